# Optimizing an MI355X kernel written in HIP

```python
import math
import jax
import jax.numpy as jnp
from jax import lax
import numpy as np

D_MODEL = 1024
BATCH = 8
SEQ = 2048
DEPTH = 2

HEAD_DIM = 64
N_HEADS = D_MODEL // HEAD_DIM
N_MIXERS = 4
GROUP_HEADS = N_HEADS // N_MIXERS
GROUP_WIDTH = GROUP_HEADS * HEAD_DIM
D_FF = 4 * D_MODEL
NORM_EPS = 1e-6
Q_BLOCK = 128
NEG_INF = -1e30
FORCE = 1e30
TINY = 1e-30
N_BUCKETS = 32
MAX_DISTANCE = 128
N_BIAS_HEADS = 3 * GROUP_HEADS
MOBA_BLOCK = 256
MOBA_TOPK = 3
MOBA_Q_CHUNK = 64
NSA_KV_DIM = HEAD_DIM
CMP_LEN = 32
CMP_STRIDE = 16
CMP_HIDDEN = 256
SLC_LEN = 64
SLC_TOPN = 4
WINDOW = 512
DIFF_HALF = HEAD_DIM // 2
SPLIT_SIZES = ((GROUP_WIDTH,) * 3
               + (GROUP_WIDTH,) * 3
               + (GROUP_WIDTH,)
               + (NSA_KV_DIM,) * 6
               + (3 * GROUP_HEADS,)
               + (GROUP_WIDTH,) * 3)
D_IN = sum(SPLIT_SIZES)

kernel_name = "hybrid_sb_moba_nsa_diff_block"


def _rmsnorm(x, g):
    xf = x.astype(jnp.float32)
    y = xf * lax.rsqrt(jnp.mean(xf * xf, axis=-1, keepdims=True) + NORM_EPS)
    return (y * g.astype(jnp.float32)).astype(x.dtype)


def _masked_softmax(logits, mask):
    s = jnp.where(mask, logits, NEG_INF)
    m = jnp.max(s, axis=-1, keepdims=True)
    e = jnp.where(mask, jnp.exp(s - m), 0.0)
    return e / jnp.maximum(jnp.sum(e, axis=-1, keepdims=True), TINY)


def _t5_bucket(dist):
    n = jnp.maximum(dist, 0)
    max_exact = N_BUCKETS // 2
    nf = jnp.maximum(n, 1).astype(jnp.float32)
    large = max_exact + (jnp.log(nf / max_exact) / math.log(MAX_DISTANCE / max_exact)
                         * (N_BUCKETS - max_exact)).astype(jnp.int32)
    large = jnp.minimum(large, N_BUCKETS - 1)
    return jnp.where(n < max_exact, n, large)


def _rel_bias(dist, table):
    return jnp.moveaxis(table[_t5_bucket(dist)], -1, 0).astype(jnp.float32)


def _rel_bias_per_head(dist, table):
    h = table.shape[1]
    h_idx = jnp.arange(h).reshape((1, h) + (1,) * (dist.ndim - 2))
    return table.T[h_idx, _t5_bucket(dist)].astype(jnp.float32)


def _heads(t, n_heads):
    b, s, _ = t.shape
    return t.reshape(b, s, n_heads, -1).transpose(0, 2, 1, 3)


def _merge_heads(t):
    b, h, s, d = t.shape
    return t.transpose(0, 2, 1, 3).reshape(b, s, h * d)


def _q_blocks(t, block):
    b, h, s = t.shape[:3]
    t = t.reshape((b, h, s // block, block) + t.shape[3:])
    return jnp.moveaxis(t, 2, 0)


def _unblock(t):
    t = jnp.moveaxis(t, 0, 2)
    b, h, n, blk = t.shape[:4]
    return t.reshape((b, h, n * blk) + t.shape[4:])


def stick_breaking_attention(q, k, v):
    b, h, s, d = q.shape
    scale = d ** -0.5
    kpos = jnp.arange(s)

    def one_block(args):
        qb, i = args
        qpos = i * Q_BLOCK + jnp.arange(Q_BLOCK)
        z = jnp.einsum('bhqd,bhkd->bhqk', qb, k).astype(jnp.float32) * scale
        mask = kpos[None, :] < qpos[:, None]
        log_keep = jnp.where(mask, -jax.nn.softplus(z), 0.0)
        suffix = lax.cumsum(log_keep, axis=3, reverse=True) - log_keep
        a = jnp.where(mask, jnp.exp(jax.nn.log_sigmoid(z) + suffix), 0.0)
        return jnp.einsum('bhqk,bhkd->bhqd', a.astype(v.dtype), v)

    out = lax.map(one_block, (_q_blocks(q, Q_BLOCK), jnp.arange(s // Q_BLOCK)))
    return _unblock(out)


def moba_attention(q, k, v, table):
    b, h, s, d = q.shape
    scale = d ** -0.5
    n_blk = -(-s // MOBA_BLOCK)
    pad = n_blk * MOBA_BLOCK - s
    k_blk = jnp.pad(k, ((0, 0), (0, 0), (0, pad), (0, 0))).reshape(b, h, n_blk, MOBA_BLOCK, d)
    v_blk = jnp.pad(v, ((0, 0), (0, 0), (0, pad), (0, 0))).reshape(b, h, n_blk, MOBA_BLOCK, d)
    k_mean = jnp.mean(k_blk.astype(jnp.float32), axis=3)
    n_sel = min(MOBA_TOPK, n_blk - 1)
    blk_ids = jnp.arange(n_blk)
    in_blk = jnp.arange(MOBA_BLOCK)
    b_idx = jnp.arange(b)[:, None, None, None]
    h_idx = jnp.arange(h)[None, :, None, None]

    def one_chunk(args):
        qc, i = args
        qpos = i * MOBA_Q_CHUNK + jnp.arange(MOBA_Q_CHUNK)
        own = (i * MOBA_Q_CHUNK) // MOBA_BLOCK
        k_own = lax.dynamic_index_in_dim(k_blk, own, axis=2, keepdims=False)
        v_own = lax.dynamic_index_in_dim(v_blk, own, axis=2, keepdims=False)
        dist_own = qpos[:, None] - (own * MOBA_BLOCK + in_blk)[None, :]
        s_own = (jnp.einsum('bhqd,bhkd->bhqk', qc, k_own).astype(jnp.float32) * scale
                 + _rel_bias(dist_own, table)[None])
        m_own = jnp.broadcast_to(dist_own >= 0, s_own.shape)
        if n_sel == 0:
            p = _masked_softmax(s_own, m_own)
            return jnp.einsum('bhqk,bhkd->bhqd', p.astype(v.dtype), v_own)
        gate = jnp.einsum('bhqd,bhnd->bhqn', qc.astype(jnp.float32), k_mean)
        gate = jnp.where(blk_ids < own, gate, NEG_INF)
        _, sel = lax.top_k(gate, n_sel)
        k_sel = k_blk[b_idx, h_idx, sel]
        v_sel = v_blk[b_idx, h_idx, sel]
        sel_pos = sel[..., None] * MOBA_BLOCK + in_blk
        dist_sel = qpos[:, None, None] - sel_pos
        s_sel = (jnp.einsum('bhqd,bhqnkd->bhqnk', qc, k_sel).astype(jnp.float32) * scale
                 + _rel_bias_per_head(dist_sel, table))
        m_sel = jnp.broadcast_to((sel < own)[..., None], s_sel.shape)
        n_flat = n_sel * MOBA_BLOCK
        s_all = jnp.concatenate([s_sel.reshape(b, h, MOBA_Q_CHUNK, n_flat), s_own], axis=-1)
        m_all = jnp.concatenate([m_sel.reshape(b, h, MOBA_Q_CHUNK, n_flat), m_own], axis=-1)
        p = _masked_softmax(s_all, m_all)
        p_sel = p[..., :n_flat].reshape(s_sel.shape)
        p_own = p[..., n_flat:]
        return (jnp.einsum('bhqnk,bhqnkd->bhqd', p_sel.astype(v.dtype), v_sel)
                + jnp.einsum('bhqk,bhkd->bhqd', p_own.astype(v.dtype), v_own))

    out = lax.map(one_chunk, (_q_blocks(q, MOBA_Q_CHUNK), jnp.arange(s // MOBA_Q_CHUNK)))
    return _unblock(out)


def nsa_attention(q, k_c, v_c, k_s, v_s, k_w, v_w, gates, pos_k, pos_v, wk1, wk2, wv1, wv2, table):
    b, h, s, d = q.shape
    scale = d ** -0.5
    tpos = jnp.arange(s)
    n_cmp = (s - CMP_LEN) // CMP_STRIDE + 1
    cmp_idx = np.arange(n_cmp)[:, None] * CMP_STRIDE + np.arange(CMP_LEN)[None, :]
    cmp_end = jnp.asarray(cmp_idx[:, -1])

    def compress(t, pos, w1, w2):
        blocks = t[:, cmp_idx] + pos
        return jax.nn.gelu(blocks.reshape(b, n_cmp, CMP_LEN * d) @ w1) @ w2

    kc = compress(k_c, pos_k, wk1, wk2)
    vc = compress(v_c, pos_v, wv1, wv2)
    dist_c = tpos[:, None] - cmp_end[None, :]
    s_c = (jnp.einsum('bhtd,bcd->bhtc', q, kc).astype(jnp.float32) * scale
           + _rel_bias(dist_c, table)[None])
    p_c = _masked_softmax(s_c, dist_c >= 0)
    o_cmp = jnp.einsum('bhtc,bcd->bhtd', p_c.astype(vc.dtype), vc)
    n_slc = s // SLC_LEN
    n_top = min(SLC_TOPN, n_slc)
    s_start = np.arange(n_slc) * SLC_LEN
    cover = np.clip(np.minimum(cmp_idx[:, -1][:, None], (s_start + SLC_LEN - 1)[None, :])
                    - np.maximum(cmp_idx[:, 0][:, None], s_start[None, :]) + 1, 0, None) / CMP_LEN
    importance = jnp.einsum('btc,cj->btj', jnp.sum(p_c, axis=1), jnp.asarray(cover, jnp.float32))
    own = tpos // SLC_LEN
    blk = jnp.arange(n_slc)
    imp = jnp.where(blk[None, :] == own[:, None], FORCE,
                    jnp.where(blk[None, :] < own[:, None], importance, NEG_INF))
    _, sel = lax.top_k(imp, n_top)
    n_qb = s // Q_BLOCK
    sel_b = sel.reshape(b, n_qb, Q_BLOCK, n_top).transpose(1, 0, 2, 3)
    ks_blk = k_s.reshape(b, n_slc, SLC_LEN, d)
    vs_blk = v_s.reshape(b, n_slc, SLC_LEN, d)
    kw_pad = jnp.pad(k_w, ((0, 0), (WINDOW, 0), (0, 0)))
    vw_pad = jnp.pad(v_w, ((0, 0), (WINDOW, 0), (0, 0)))
    b_idx = jnp.arange(b)[:, None, None]
    in_slc = jnp.arange(SLC_LEN)
    in_win = jnp.arange(WINDOW + Q_BLOCK)

    def one_block(args):
        qb, selc, i = args
        qpos = i * Q_BLOCK + jnp.arange(Q_BLOCK)
        k_sel = ks_blk[b_idx, selc]
        v_sel = vs_blk[b_idx, selc]
        dist_s = qpos[:, None, None] - (selc[..., None] * SLC_LEN + in_slc)
        s_s = (jnp.einsum('bhqd,bqnkd->bhqnk', qb, k_sel).astype(jnp.float32) * scale
               + jnp.moveaxis(table[_t5_bucket(dist_s)], -1, 1).astype(jnp.float32))
        m_s = jnp.broadcast_to((dist_s >= 0)[:, None], s_s.shape)
        flat = (b, h, Q_BLOCK, n_top * SLC_LEN)
        p_s = _masked_softmax(s_s.reshape(flat), m_s.reshape(flat)).reshape(s_s.shape)
        o_s = jnp.einsum('bhqnk,bqnkd->bhqd', p_s.astype(v_sel.dtype), v_sel)
        kw = lax.dynamic_slice_in_dim(kw_pad, i * Q_BLOCK, WINDOW + Q_BLOCK, axis=1)
        vw = lax.dynamic_slice_in_dim(vw_pad, i * Q_BLOCK, WINDOW + Q_BLOCK, axis=1)
        kpos = i * Q_BLOCK - WINDOW + in_win
        dist_w = qpos[:, None] - kpos[None, :]
        m_w = (dist_w >= 0) & (dist_w < WINDOW) & (kpos[None, :] >= 0)
        s_w = (jnp.einsum('bhqd,bkd->bhqk', qb, kw).astype(jnp.float32) * scale
               + _rel_bias(dist_w, table)[None])
        p_w = _masked_softmax(s_w, m_w)
        o_w = jnp.einsum('bhqk,bkd->bhqd', p_w.astype(vw.dtype), vw)
        return o_s, o_w

    o_slc, o_win = lax.map(one_block, (_q_blocks(q, Q_BLOCK), sel_b, jnp.arange(n_qb)))
    o_slc, o_win = _unblock(o_slc), _unblock(o_win)
    g = jax.nn.sigmoid(gates.astype(jnp.float32)).reshape(b, s, 3, h).transpose(2, 0, 3, 1)[..., None]
    g = g.astype(q.dtype)
    return g[0] * o_cmp + g[1] * o_slc + g[2] * o_win


def diff_attention(q, k, v, lam, table):
    s = q.shape[2]
    scale = q.shape[-1] ** -0.5
    kpos = jnp.arange(s)

    def one_block(args):
        qb, i = args
        qpos = i * Q_BLOCK + jnp.arange(Q_BLOCK)
        dist = qpos[:, None] - kpos[None, :]
        sc = (jnp.einsum('bhqcd,bhkcd->bhcqk', qb, k).astype(jnp.float32) * scale
              + _rel_bias(dist, table)[None, :, None])
        p = _masked_softmax(sc, dist >= 0)
        w = p[:, :, 0] - lam * p[:, :, 1]
        return jnp.einsum('bhqk,bhkd->bhqd', w.astype(v.dtype), v)

    out = lax.map(one_block, (_q_blocks(q, Q_BLOCK), jnp.arange(s // Q_BLOCK)))
    return _unblock(out)


def setup_inputs(seed: int = 0) -> dict:
    key = jax.random.key(seed)
    ks = jax.random.split(key, 17)
    f32 = jnp.float32

    def nrm(k, shape, scale):
        return jax.random.normal(k, shape, f32) * scale

    return {
        "x": nrm(ks[0], (BATCH, SEQ, D_MODEL), 1.0),
        "w_in": nrm(ks[1], (DEPTH, D_MODEL, D_IN), D_MODEL ** -0.5),
        "w_out": nrm(ks[2], (DEPTH, D_MODEL, D_MODEL), D_MODEL ** -0.5),
        "w_up": nrm(ks[3], (DEPTH, D_MODEL, D_FF), D_MODEL ** -0.5),
        "w_down": nrm(ks[4], (DEPTH, D_FF, D_MODEL), D_FF ** -0.5),
        "norm_attn": 1.0 + nrm(ks[5], (DEPTH, D_MODEL), 0.05),
        "norm_mlp": 1.0 + nrm(ks[6], (DEPTH, D_MODEL), 0.05),
        "cmp_pos_k": nrm(ks[7], (DEPTH, CMP_LEN, HEAD_DIM), 0.1),
        "cmp_pos_v": nrm(ks[8], (DEPTH, CMP_LEN, HEAD_DIM), 0.1),
        "cmp_k_w1": nrm(ks[9], (DEPTH, CMP_LEN * HEAD_DIM, CMP_HIDDEN), (CMP_LEN * HEAD_DIM) ** -0.5),
        "cmp_k_w2": nrm(ks[10], (DEPTH, CMP_HIDDEN, HEAD_DIM), CMP_HIDDEN ** -0.5),
        "cmp_v_w1": nrm(ks[11], (DEPTH, CMP_LEN * HEAD_DIM, CMP_HIDDEN), (CMP_LEN * HEAD_DIM) ** -0.5),
        "cmp_v_w2": nrm(ks[12], (DEPTH, CMP_HIDDEN, HEAD_DIM), CMP_HIDDEN ** -0.5),
        "diff_lambda": nrm(ks[13], (DEPTH, 4, DIFF_HALF), 0.1),
        "diff_subln": 1.0 + nrm(ks[14], (DEPTH, HEAD_DIM), 0.05),
        "rel_bias": nrm(ks[15], (N_BUCKETS, N_BIAS_HEADS), 0.2),
        "final_norm": 1.0 + nrm(ks[16], (D_MODEL,), 0.05),
    }


def reference(x, w_in, w_out, w_up, w_down, norm_attn, norm_mlp, cmp_pos_k, cmp_pos_v,
              cmp_k_w1, cmp_k_w2, cmp_v_w1, cmp_v_w2, diff_lambda, diff_subln, rel_bias, final_norm):
    bias_moba = rel_bias[:, :GROUP_HEADS]
    bias_nsa = rel_bias[:, GROUP_HEADS:2 * GROUP_HEADS]
    bias_diff = rel_bias[:, 2 * GROUP_HEADS:]
    split_at = np.cumsum(SPLIT_SIZES)[:-1].tolist()
    b, s, _ = x.shape
    for layer in range(DEPTH):
        h = _rmsnorm(x, norm_attn[layer])
        proj = h @ w_in[layer]
        (sb_q, sb_k, sb_v, mb_q, mb_k, mb_v, ns_q, ns_kc, ns_vc, ns_ks, ns_vs, ns_kw, ns_vw,
         ns_g, df_q, df_k, df_v) = jnp.split(proj, split_at, axis=-1)
        o_sb = stick_breaking_attention(_heads(sb_q, GROUP_HEADS), _heads(sb_k, GROUP_HEADS),
                                        _heads(sb_v, GROUP_HEADS))
        o_mb = moba_attention(_heads(mb_q, GROUP_HEADS), _heads(mb_k, GROUP_HEADS),
                              _heads(mb_v, GROUP_HEADS), bias_moba)
        o_ns = nsa_attention(_heads(ns_q, GROUP_HEADS), ns_kc, ns_vc, ns_ks, ns_vs, ns_kw, ns_vw, ns_g,
                             cmp_pos_k[layer], cmp_pos_v[layer], cmp_k_w1[layer], cmp_k_w2[layer],
                             cmp_v_w1[layer], cmp_v_w2[layer], bias_nsa)
        lambda_init = 0.8 - 0.6 * math.exp(-0.3 * layer)
        lv = diff_lambda[layer].astype(jnp.float32)
        lam = jnp.exp(jnp.sum(lv[0] * lv[1])) - jnp.exp(jnp.sum(lv[2] * lv[3])) + lambda_init
        dq = df_q.reshape(b, s, GROUP_HEADS, 2, DIFF_HALF).transpose(0, 2, 1, 3, 4)
        dk = df_k.reshape(b, s, GROUP_HEADS, 2, DIFF_HALF).transpose(0, 2, 1, 3, 4)
        o_df = diff_attention(dq, dk, _heads(df_v, GROUP_HEADS), lam, bias_diff)
        o_df = _rmsnorm(o_df, diff_subln[layer]) * (1.0 - lambda_init)
        mixed = jnp.concatenate([_merge_heads(o_sb), _merge_heads(o_mb),
                                 _merge_heads(o_ns), _merge_heads(o_df)], axis=-1)
        x = x + mixed @ w_out[layer]
        h2 = _rmsnorm(x, norm_mlp[layer])
        x = x + jnp.square(jax.nn.relu(h2 @ w_up[layer])) @ w_down[layer]
    return _rmsnorm(x, final_norm)
```

```cpp
#include <hip/hip_runtime.h>
#include <hip/hip_cooperative_groups.h>
#include <cstdio>
#include <cstdint>
namespace cg = cooperative_groups;

namespace pg8 {
#define PG8_LAS __attribute__((address_space(3)))
typedef unsigned short bf16_t;
typedef short bf16x8 __attribute__((ext_vector_type(8)));
typedef float f32x4 __attribute__((ext_vector_type(4)));
typedef unsigned u32x4 __attribute__((ext_vector_type(4)));
constexpr int BM = 256, BK = 64, HALF = 128, HTB = HALF * BK * 2  , STAGE_BYTES = 8 * HTB, NXCD = 8, WGM = 8;

__host__ __device__ __forceinline__ int lds_byte(int r, int c) { const int st = (r >> 4) * 2 + (c >> 5), rr = r & 15, cc = c & 31, ob = rr * 64 + cc * 2; return st * 1024 + (ob ^ (((ob >> 9) & 1) << 5)); }
__host__ __device__ __forceinline__ void stage_rc(int b, int& R, int& C) { const int st = b / 1024, sb = b % 1024, swz = sb ^ (((sb >> 9) & 1) << 5); R = (st >> 1) * 16 + swz / 64; C = (st & 1) * 32 + (swz % 64) / 2; }
__host__ __device__ __forceinline__ int perm32(int rho) { const int n = rho >> 4, i = rho & 15; return 8 * (i >> 2) + 4 * n + (i & 3); }

struct Unit { int pm, pn; };
struct Gemm { const bf16_t* A; const bf16_t* Bt; int M, N, K; };

struct StaticOrder {
    int nM, nN, nwg, G, c;
    __host__ __device__ void init(int M, int N, int G_, int c_) { nM = M / BM; nN = N / BM; nwg = nM * nN; G = G_; c = c_; }
    __host__ __device__ bool next(int i, Unit& u) const {
        const long L = (long)i * G + c; if (L >= nwg) return false;
        int wgid = (int)L; { const int q = nwg / NXCD, r = nwg % NXCD, xcd = wgid % NXCD, off = wgid / NXCD; wgid = (xcd < r ? xcd * (q + 1) : r * (q + 1) + (xcd - r) * q) + off; }
        const int nig = WGM * nN, gid = wgid / nig, fm = gid * WGM, gsz = (nM - fm) < WGM ? (nM - fm) : WGM;
        u.pm = fm + ((wgid % nig) % gsz); u.pn = (wgid % nig) / gsz; return true;
    }
    __device__ __forceinline__ void a_ready(const Unit&) const {}
    __device__ __forceinline__ void done(const Unit&) const {}
};


__device__ __forceinline__ unsigned cvt_pk_bf16(float lo, float hi) { unsigned r; asm volatile("v_cvt_pk_bf16_f32 %0, %1, %2" : "=v"(r) : "v"(lo), "v"(hi)); return r; }
constexpr float NORM_EPS = 1e-6f;
template <int ACT> struct EpiScale {
    static constexpr bool PERM = true, AFTER_DRAIN = false;
    bf16_t* O; int ldc; const float* rowss; float inv_d;
    __device__ __forceinline__ void operator()(const f32x4 (&acc)[2][2][4][2], const Unit& u, int wr, int wc, int fr, int fq) const {
        const int row0 = u.pm * BM + wr * 64 + fr, col0 = u.pn * BM + wc * 32 + 8 * fq;
#pragma unroll
        for (int ai = 0; ai < 2; ++ai)
#pragma unroll
            for (int m = 0; m < 4; ++m) { const int row = row0 + ai * HALF + m * 16; const float rs = 1.0f / sqrtf(rowss[row] * inv_d + NORM_EPS);
                bf16_t* rowp = O + (size_t)row * ldc + col0;
#pragma unroll
                for (int bj = 0; bj < 2; ++bj) { f32x4 v0 = acc[ai][bj][m][0] * rs, v1 = acc[ai][bj][m][1] * rs;
                    if (ACT == 1) {
#pragma unroll
                        for (int e = 0; e < 4; ++e) { const float a = fmaxf(v0[e], 0.f), b = fmaxf(v1[e], 0.f); v0[e] = a * a; v1[e] = b * b; } }
                    u32x4 w; w.x = cvt_pk_bf16(v0[0], v0[1]); w.y = cvt_pk_bf16(v0[2], v0[3]); w.z = cvt_pk_bf16(v1[0], v1[1]); w.w = cvt_pk_bf16(v1[2], v1[3]);
                    *(u32x4*)(rowp + bj * HALF) = w; } }
    }
};
struct EpiResidual {
    static constexpr bool PERM = true, AFTER_DRAIN = false;
    const float* xin; float* xout; bf16_t* xb; float* rowss_out; int ldc;
    __device__ __forceinline__ void operator()(const f32x4 (&acc)[2][2][4][2], const Unit& u, int wr, int wc, int fr, int fq) const {
        const int row0 = u.pm * BM + wr * 64 + fr, col0 = u.pn * BM + wc * 32 + 8 * fq;
#pragma unroll
        for (int ai = 0; ai < 2; ++ai)
#pragma unroll
            for (int m = 0; m < 4; ++m) { const int row = row0 + ai * HALF + m * 16; const size_t off = (size_t)row * ldc + col0; float ss = 0.f;
#pragma unroll
                for (int bj = 0; bj < 2; ++bj) { const f32x4 r0 = *(const f32x4*)(xin + off + bj * HALF), r1 = *(const f32x4*)(xin + off + bj * HALF + 4);
                    const f32x4 v0 = r0 + acc[ai][bj][m][0], v1 = r1 + acc[ai][bj][m][1];
                    *(f32x4*)(xout + off + bj * HALF) = v0; *(f32x4*)(xout + off + bj * HALF + 4) = v1;
                    u32x4 w; w.x = cvt_pk_bf16(v0[0], v0[1]); w.y = cvt_pk_bf16(v0[2], v0[3]); w.z = cvt_pk_bf16(v1[0], v1[1]); w.w = cvt_pk_bf16(v1[2], v1[3]);
                    *(u32x4*)(xb + off + bj * HALF) = w;
                    ss += (v0[0] * v0[0] + v0[1] * v0[1]) + (v0[2] * v0[2] + v0[3] * v0[3]) + (v1[0] * v1[0] + v1[1] * v1[1]) + (v1[2] * v1[2] + v1[3] * v1[3]); }
                ss += __shfl_xor(ss, 16); ss += __shfl_xor(ss, 32);
                if (fq == 0) atomicAdd(rowss_out + row, ss); }
    }
};

template <class Epi, class Sched, bool ALIGN_EPI = false, bool SP2 = false>
__device__ __forceinline__ void gemm_phase(PG8_LAS unsigned char* lds, const Gemm g, const Sched& S, const Epi& E) {
    int tid_o = threadIdx.x; asm volatile("" : "+v"(tid_o));
    const int tid = tid_o, wid = __builtin_amdgcn_readfirstlane(tid >> 6), lane = tid & 63, wr = wid >> 2, wc = wid & 3, fr = lane & 15, fq = lane >> 4;
    const int K = g.K, nt = K / BK;
    unsigned voffA[2], voffB[2];
#pragma unroll
    for (int i = 0; i < 2; ++i) { int R, C; stage_rc(tid * 16 + i * 8192, R, C); const int Rb = Epi::PERM ? ((R & ~31) + perm32(R & 31)) : R;
        voffA[i] = (unsigned)(R * K + C) * 2u; voffB[i] = (unsigned)(Rb * K + C) * 2u; }
    const size_t kstep = (size_t)(BK * 2);
    const size_t hstep = (size_t)HALF * K * 2;
    const size_t tstep = 2 * hstep;
    const unsigned ldsw = (unsigned)wid * 1024u;
    const int aoff = lds_byte(wr * 64 + fr, fq * 8), boff = lds_byte(wc * 32 + fr, fq * 8);
#define PG8_SA(b, h) (((b) * 2 + (h)) * HTB)
#define PG8_SB(b, h) ((4 + (b) * 2 + (h)) * HTB)
#define PG8_STAGE(bufoff, gbase, voff) do { _Pragma("unroll") for (int _i = 0; _i < 2; ++_i) \
        __builtin_amdgcn_global_load_lds((const unsigned*)((const char*)(gbase) + (voff)[_i]), (PG8_LAS unsigned*)(lds + (bufoff) + ldsw + _i * 8192), 16, 0, 0); } while (0)
#define PG8_LDA(dst, b, h) do { _Pragma("unroll") for (int m = 0; m < 4; ++m) _Pragma("unroll") for (int k = 0; k < 2; ++k) dst[m][k] = *(const PG8_LAS bf16x8*)(lds + PG8_SA(b, h) + aoff + m * 2048 + k * 1024); } while (0)
#define PG8_LDB(dst, b, h) do { _Pragma("unroll") for (int n = 0; n < 2; ++n) _Pragma("unroll") for (int k = 0; k < 2; ++k) dst[n][k] = *(const PG8_LAS bf16x8*)(lds + PG8_SB(b, h) + boff + n * 2048 + k * 1024); } while (0)
#define PG8_MMA(ai, bj, At, Bt) do { __builtin_amdgcn_s_setprio(1); _Pragma("unroll") for (int m = 0; m < 4; ++m) _Pragma("unroll") for (int n = 0; n < 2; ++n) _Pragma("unroll") for (int k = 0; k < 2; ++k) \
        acc[ai][bj][m][n] = __builtin_amdgcn_mfma_f32_16x16x32_bf16(Bt[n][k], At[m][k], acc[ai][bj][m][n], 0, 0, 0); __builtin_amdgcn_s_setprio(0); } while (0)
#define PG8_WAIT_V(n) asm volatile("s_waitcnt vmcnt(" #n ")" ::: "memory")
#define PG8_WAIT_L(n) asm volatile("s_waitcnt lgkmcnt(" #n ")" ::: "memory")
#define PG8_BAR __builtin_amdgcn_s_barrier()
#define PG8_SCHED __builtin_amdgcn_sched_barrier(0)
    Unit cur, nxt; int ui = 0;
    if (!S.next(0, cur)) return;
    f32x4 acc[2][2][4][2];
#pragma unroll
    for (int a = 0; a < 2; ++a)
#pragma unroll
        for (int b = 0; b < 2; ++b)
#pragma unroll
            for (int m = 0; m < 4; ++m)
#pragma unroll
                for (int n = 0; n < 2; ++n) acc[a][b][m][n] = (f32x4){0.f, 0.f, 0.f, 0.f};
    bf16x8 At[4][2], B0[2][2], B1[2][2];
    const char* cA = (const char*)g.A + (size_t)cur.pm * tstep; const char* cB = (const char*)g.Bt + (size_t)cur.pn * tstep;
    S.a_ready(cur);
    if constexpr (SP2) {
        PG8_STAGE(PG8_SB(0, 0), cB, voffB); PG8_STAGE(PG8_SB(0, 1), cB + hstep, voffB); PG8_STAGE(PG8_SA(0, 0), cA, voffA); PG8_STAGE(PG8_SA(0, 1), cA + hstep, voffA);
        if (wr == 1) PG8_BAR;
        PG8_WAIT_V(2); PG8_BAR;
        PG8_STAGE(PG8_SB(1, 0), cB + kstep, voffB); PG8_STAGE(PG8_SA(1, 0), cA + kstep, voffA); PG8_STAGE(PG8_SB(1, 1), cB + hstep + kstep, voffB);
        PG8_WAIT_V(6); PG8_BAR;
    } else {
        PG8_STAGE(PG8_SB(0, 0), cB, voffB); PG8_STAGE(PG8_SA(0, 0), cA, voffA); PG8_STAGE(PG8_SB(0, 1), cB + hstep, voffB); PG8_STAGE(PG8_SA(0, 1), cA + hstep, voffA);
        if (wr == 1) PG8_BAR;
        PG8_WAIT_V(4); PG8_BAR;
        PG8_STAGE(PG8_SB(1, 0), cB + kstep, voffB); PG8_STAGE(PG8_SA(1, 0), cA + kstep, voffA); PG8_STAGE(PG8_SB(1, 1), cB + hstep + kstep, voffB);
        PG8_WAIT_V(6); PG8_BAR;
    }
    for (;;) {
        const bool has_next = S.next(ui + 1, nxt);
        const char* nA = has_next ? (const char*)g.A + (size_t)nxt.pm * tstep : cA; const char* nB = has_next ? (const char*)g.Bt + (size_t)nxt.pn * tstep : cB;
        for (int t = 0; t < nt; t += 2) {
            const bool last = (t == nt - 2);
            const char* a1 = cA + (size_t)(t + 1) * kstep;
            const char* a2 = last ? nA : cA + (size_t)(t + 2) * kstep; const char* b2 = last ? nB : cB + (size_t)(t + 2) * kstep;
            const char* a3 = a2 + kstep; const char* b3 = b2 + kstep;
            if (last && has_next) S.a_ready(nxt);
            if constexpr (SP2) {
            PG8_LDB(B0, 0, 0); PG8_LDB(B1, 0, 1); PG8_SCHED; PG8_LDA(At, 0, 0); PG8_STAGE(PG8_SA(1, 1), a1 + hstep, voffA);
            PG8_WAIT_V(8); PG8_WAIT_L(0); PG8_BAR; PG8_MMA(0, 0, At, B0); PG8_MMA(0, 1, At, B1); PG8_BAR; PG8_SCHED;
            PG8_LDA(At, 0, 1); PG8_STAGE(PG8_SB(0, 0), b2, voffB); PG8_STAGE(PG8_SB(0, 1), b2 + hstep, voffB); PG8_STAGE(PG8_SA(0, 0), a2, voffA);
            PG8_WAIT_V(8); PG8_WAIT_L(0); PG8_BAR; PG8_MMA(1, 0, At, B0); PG8_MMA(1, 1, At, B1); PG8_BAR; PG8_SCHED;
            PG8_LDB(B0, 1, 0); PG8_LDB(B1, 1, 1); PG8_SCHED; PG8_LDA(At, 1, 0); PG8_STAGE(PG8_SA(0, 1), a2 + hstep, voffA);
            PG8_WAIT_V(8); PG8_WAIT_L(0); PG8_BAR; PG8_MMA(0, 0, At, B0); PG8_MMA(0, 1, At, B1); PG8_BAR; PG8_SCHED;
            PG8_LDA(At, 1, 1); PG8_STAGE(PG8_SB(1, 0), b3, voffB); PG8_STAGE(PG8_SB(1, 1), b3 + hstep, voffB); PG8_STAGE(PG8_SA(1, 0), a3, voffA);
            PG8_WAIT_V(8); PG8_WAIT_L(0); PG8_BAR; PG8_MMA(1, 0, At, B0); PG8_MMA(1, 1, At, B1); PG8_BAR; PG8_SCHED;
            } else {
            PG8_LDB(B0, 0, 0); PG8_SCHED; PG8_LDA(At, 0, 0); PG8_STAGE(PG8_SA(1, 1), a1 + hstep, voffA);
            PG8_WAIT_L(8); PG8_BAR; PG8_WAIT_L(0); PG8_MMA(0, 0, At, B0); PG8_BAR; PG8_SCHED;
            PG8_LDB(B1, 0, 1); PG8_STAGE(PG8_SB(0, 0), b2, voffB);
            PG8_BAR; PG8_WAIT_L(0); PG8_MMA(0, 1, At, B1); PG8_BAR;
            PG8_LDA(At, 0, 1); PG8_STAGE(PG8_SA(0, 0), a2, voffA);
            PG8_BAR; PG8_WAIT_L(0); PG8_MMA(1, 0, At, B0); PG8_BAR; PG8_SCHED;
            PG8_STAGE(PG8_SB(0, 1), b2 + hstep, voffB);
            PG8_WAIT_V(6); PG8_BAR; PG8_MMA(1, 1, At, B1); PG8_BAR;
            PG8_LDB(B0, 1, 0); PG8_SCHED; PG8_LDA(At, 1, 0); PG8_STAGE(PG8_SA(0, 1), a2 + hstep, voffA);
            PG8_WAIT_L(8); PG8_BAR; PG8_WAIT_L(0); PG8_MMA(0, 0, At, B0); PG8_BAR; PG8_SCHED;
            PG8_LDB(B1, 1, 1); PG8_STAGE(PG8_SB(1, 0), b3, voffB);
            PG8_BAR; PG8_WAIT_L(0); PG8_MMA(0, 1, At, B1); PG8_BAR;
            PG8_LDA(At, 1, 1); PG8_STAGE(PG8_SA(1, 0), a3, voffA);
            PG8_BAR; PG8_WAIT_L(0); PG8_MMA(1, 0, At, B0); PG8_BAR; PG8_SCHED;
            PG8_STAGE(PG8_SB(1, 1), b3 + hstep, voffB);
            PG8_WAIT_V(6); PG8_BAR; PG8_MMA(1, 1, At, B1); PG8_BAR;
            }
        }
        if constexpr (ALIGN_EPI) { if (wr == 0) PG8_BAR; }
        if constexpr (!Epi::AFTER_DRAIN) { E(acc, cur, wr, wc, fr, fq); S.done(cur); }
        if (!has_next) break;
#pragma unroll
        for (int a = 0; a < 2; ++a)
#pragma unroll
            for (int b = 0; b < 2; ++b)
#pragma unroll
                for (int m = 0; m < 4; ++m)
#pragma unroll
                    for (int n = 0; n < 2; ++n) acc[a][b][m][n] = (f32x4){0.f, 0.f, 0.f, 0.f};
        cur = nxt; cA = nA; cB = nB; ++ui;
        if constexpr (ALIGN_EPI) { if (wr == 1) PG8_BAR; }
    }
    PG8_WAIT_V(0);
    if constexpr (!ALIGN_EPI) { if (wr == 0) PG8_BAR; }
    PG8_BAR;
    if constexpr (Epi::AFTER_DRAIN) { E.fused(acc, cur, wr, wc, fr, fq, lds, wid, lane); S.done(cur); }
#undef PG8_SA
#undef PG8_SB
#undef PG8_STAGE
#undef PG8_LDA
#undef PG8_LDB
#undef PG8_MMA
#undef PG8_WAIT_V
#undef PG8_WAIT_L
#undef PG8_BAR
#undef PG8_SCHED
}
}

#define LAS __attribute__((address_space(3)))
typedef unsigned short bf16_t;
typedef unsigned u32x4 __attribute__((ext_vector_type(4)));
typedef float f32x4 __attribute__((ext_vector_type(4)));
constexpr int BATCH = 8, SEQ = 2048, DM = 1024, DEPTH = 2, HD = 64, DFF = 4096, M_TOK = BATCH * SEQ;
constexpr int D_IN = 2956, LDP = 3072;
constexpr int C_SBQ = 0, C_SBK = 256, C_SBV = 512, C_MBQ = 768, C_MBK = 1024, C_MBV = 1280, C_NSQ = 1536, C_NKC = 1792, C_NVC = 1856, C_NKS = 1920, C_NVS = 1984,
              C_NKW = 2048, C_NVW = 2112, C_DFQ = 2176, C_DFK = 2432, C_DFV = 2688, C_NSG = 2944;
constexpr int N_CMP = 127;
constexpr float NEG_BIG = -1e30f, TINY = 1e-30f;
constexpr size_t MiB = 1u << 20;
constexpr size_t WS_ROWSS = 1 * MiB;
constexpr size_t WS_BIAS = 1 * MiB + 512 * 1024;
constexpr size_t WS_ORDER = WS_BIAS + 48 * 1024;
constexpr size_t WS_QCTR = 14336;
constexpr size_t WS_LAM = WS_BIAS + 32 * 1024;
constexpr size_t WS_KMEAN = WS_BIAS + 64 * 1024;
constexpr size_t WS_KC = 2 * MiB, WS_VC = 2 * MiB + 128 * 1024;
constexpr size_t WS_CW1 = 3 * MiB, WS_CW2 = 7 * MiB;
constexpr size_t WS_WIN = 8 * MiB, WS_WOUT = 20 * MiB, WS_WUP = 24 * MiB, WS_WDOWN = 40 * MiB;
constexpr size_t WS_PROJ = 56 * MiB;
constexpr size_t WS_NSATMP = WS_PROJ + 96 * MiB;
constexpr size_t WS_MIXED = 184 * MiB, WS_XB = 216 * MiB, WS_END = 248 * MiB;
constexpr int LDS_BYTES = 147456;

struct Args { const float* in[17]; float* out; unsigned char* ws; };

__device__ __forceinline__ float bflo(unsigned u) { return __uint_as_float(u << 16); }
__device__ __forceinline__ float bfhi(unsigned u) { return __uint_as_float(u & 0xffff0000u); }
__device__ __forceinline__ unsigned f2bf(float f) { unsigned u = __float_as_uint(f); return (u + 0x7fffu + ((u >> 16) & 1u)) >> 16; }
__device__ __forceinline__ unsigned pk2(float lo, float hi) { return f2bf(lo) | (f2bf(hi) << 16); }
__device__ __forceinline__ float wave_sum(float v) {
#pragma unroll
    for (int o = 1; o < 64; o <<= 1) v += __shfl_xor(v, o);
    return v;
}
__device__ __forceinline__ int t5_bucket(int n) {
    if (n < 16) return n;
    const int large = 16 + (int)(logf((float)n * (1.0f / 16.0f)) / 2.0794415416798357f * 16.0f);
    return large < 31 ? large : 31;
}

constexpr size_t WS_BAR = 0;
#define XB_TMO      128
#define XB_XCNT(j)  (256  + 64 * (j))
#define XB_XSUB(j)  (1280 + 64 * (j))
#define XB_XGEN(j)  (2304 + 64 * (j))
#define XB_TOP      3328
#define XB_TOPGEN   3392
#define XCD_BAR_WORDS 3456
#define XB_SPIN_CAP (1u << 18)

__device__ __forceinline__ unsigned xb_ld(unsigned* p)              { return __hip_atomic_load(p, __ATOMIC_RELAXED, __HIP_MEMORY_SCOPE_AGENT); }
__device__ __forceinline__ unsigned xb_add(unsigned* p, unsigned v) { return __hip_atomic_fetch_add(p, v, __ATOMIC_RELAXED, __HIP_MEMORY_SCOPE_AGENT); }
__device__ __forceinline__ unsigned xb_xcc_id() { return (unsigned)__builtin_amdgcn_s_getreg((3 << 11) | 20) & 0xFu; }
#define XB_SPIN(cond, bar) do { unsigned _sp = 0; while (cond) { __builtin_amdgcn_s_sleep(1); \
    if ((++_sp & 255u) == 0u) { if (xb_ld(&(bar)[XB_TMO])) break; if (_sp > XB_SPIN_CAP) { atomicAdd(&(bar)[XB_TMO], 1u); break; } } } } while (0)

struct XcdBarrier {
    unsigned* bar; unsigned x;
    volatile LAS unsigned* st;
};

__device__ __forceinline__ XcdBarrier xcd_barrier_post(unsigned* bar, volatile LAS unsigned* st) {
    XcdBarrier b; b.bar = bar; b.x = xb_xcc_id(); b.st = st;
    if (threadIdx.x == 0) (void)xb_add(&bar[XB_XCNT(b.x)], 1u);
    return b;
}
__device__ __forceinline__ void xcd_barrier_complete(unsigned* bar, unsigned x, unsigned& nloc, unsigned& nx) {
    const unsigned G = gridDim.x * gridDim.y * gridDim.z;
    unsigned sum, cnt, mine, sp = 0u;
    for (;;) {
        sum = 0u; cnt = 0u; mine = 0u;
#pragma unroll
        for (unsigned j = 0; j < 16; ++j) { const unsigned c = xb_ld(&bar[XB_XCNT(j)]); sum += c; cnt += (c > 0u) ? 1u : 0u; mine = (j == x) ? c : mine; }
        if (sum == G) break;
        __builtin_amdgcn_s_sleep(1);
        if ((++sp & 255u) == 0u) { if (xb_ld(&bar[XB_TMO])) break; if (sp > XB_SPIN_CAP) { atomicAdd(&bar[XB_TMO], 1u); break; } }
    }
    nloc = mine > 0u ? mine : 1u; nx = cnt > 0u ? cnt : 1u;
}

__device__ __forceinline__ void xcd_barrier(const XcdBarrier& b) {
    asm volatile("s_waitcnt vmcnt(0)" ::: "memory");
    __syncthreads();
    if (threadIdx.x == 0) {
        unsigned* bar = b.bar;
        __builtin_amdgcn_s_waitcnt(0);
        unsigned nloc = b.st[0], nx = b.st[1];
        if (nloc == 0u) { xcd_barrier_complete(bar, b.x, nloc, nx); b.st[0] = nloc; b.st[1] = nx; }
        const unsigned old = xb_add(&bar[XB_XSUB(b.x)], 1u);
        const unsigned gen = old / nloc;
        if (old + 1u == (gen + 1u) * nloc) {
            __builtin_amdgcn_fence(__ATOMIC_RELEASE, "agent");
            asm volatile("s_waitcnt vmcnt(0)" ::: "memory");
            const unsigned og = xb_add(&bar[XB_TOP], 1u);
            const unsigned tg = og / nx;
            if (og + 1u == (tg + 1u) * nx) xb_add(&bar[XB_TOPGEN], 1u);
            else XB_SPIN(xb_ld(&bar[XB_TOPGEN]) == tg, bar);
            __builtin_amdgcn_fence(__ATOMIC_ACQUIRE, "agent");
            xb_add(&bar[XB_XGEN(b.x)], 1u);
            asm volatile("s_waitcnt vmcnt(0)" ::: "memory");
        } else {
            XB_SPIN(xb_ld(&bar[XB_XGEN(b.x)]) == gen, bar);
            __builtin_amdgcn_fence(__ATOMIC_ACQUIRE, "agent");
            asm volatile("s_waitcnt vmcnt(0)" ::: "memory");
        }
    }
    __syncthreads();
}

__device__ __forceinline__ float unit_cost(int id) { const int type = id >> 8, idx = id & 255;
    if (type == 0) return 5.6f * (float)((idx >> 5) + 1) + 1.0f;
    if (type == 1) { const int own = idx >> 3; return 5.0f + (float)(own + 1) + (float)(own + 1 < 9 ? own + 1 : 9); }
    if (type == 2) return 4.0f * (float)((idx >> 5) + 1) + 1.5f;
    return 9.0f; }
__device__ __forceinline__ int win_dest(int n) { return n < 2176 ? n : (n < 2188 ? 2944 + (n - 2176) : n - 12); }
template <bool MAP> __device__ __forceinline__ void transpose_item(const float* W, const float* g, bf16_t* WT, int K, int N, int kb, int nb, LAS float* scr, int lane) {
    const int k0 = kb * 64, n0 = nb * 32, nn = lane & 31; const bool inb = n0 + nn < N;
#pragma unroll 8
    for (int i = 0; i < 32; ++i) { const int kk = 2 * i + (lane >> 5); float v = inb ? W[(size_t)(k0 + kk) * N + n0 + nn] : 0.f; if (g) v *= g[k0 + kk]; scr[kk * 33 + nn] = v; }
    asm volatile("s_waitcnt lgkmcnt(0)" ::: "memory");
    const int c = lane & 7;
#pragma unroll
    for (int j = 0; j < 4; ++j) { const int n = (lane >> 3) + 8 * j; const LAS float* s = scr + (8 * c) * 33 + n;
        u32x4 o; o.x = pk2(s[0], s[33]); o.y = pk2(s[2 * 33], s[3 * 33]); o.z = pk2(s[4 * 33], s[5 * 33]); o.w = pk2(s[6 * 33], s[7 * 33]);
        if (n0 + n < N) { const int dest = MAP ? win_dest(n0 + n) : (n0 + n); *(u32x4*)(WT + (size_t)dest * K + k0 + 8 * c) = o; } }
    asm volatile("s_waitcnt lgkmcnt(0)" ::: "memory");
}

template <int NC> __device__ __forceinline__ float dotq(const float* q, const bf16_t* row) {
    const uint4* p = (const uint4*)row; float a = 0.f;
#pragma unroll
    for (int c = 0; c < NC; ++c) { const uint4 w = p[c];
        a = fmaf(q[8 * c + 0], bflo(w.x), a); a = fmaf(q[8 * c + 1], bfhi(w.x), a); a = fmaf(q[8 * c + 2], bflo(w.y), a); a = fmaf(q[8 * c + 3], bfhi(w.y), a);
        a = fmaf(q[8 * c + 4], bflo(w.z), a); a = fmaf(q[8 * c + 5], bfhi(w.z), a); a = fmaf(q[8 * c + 6], bflo(w.w), a); a = fmaf(q[8 * c + 7], bfhi(w.w), a); }
    return a;
}
__device__ __forceinline__ void axpy64(float* o, float p, const bf16_t* row) {
    const uint4* v = (const uint4*)row;
#pragma unroll
    for (int c = 0; c < 8; ++c) { const uint4 w = v[c];
        o[8 * c + 0] = fmaf(p, bflo(w.x), o[8 * c + 0]); o[8 * c + 1] = fmaf(p, bfhi(w.x), o[8 * c + 1]); o[8 * c + 2] = fmaf(p, bflo(w.y), o[8 * c + 2]); o[8 * c + 3] = fmaf(p, bfhi(w.y), o[8 * c + 3]);
        o[8 * c + 4] = fmaf(p, bflo(w.z), o[8 * c + 4]); o[8 * c + 5] = fmaf(p, bfhi(w.z), o[8 * c + 5]); o[8 * c + 6] = fmaf(p, bflo(w.w), o[8 * c + 6]); o[8 * c + 7] = fmaf(p, bfhi(w.w), o[8 * c + 7]); }
}
__device__ __forceinline__ void loadq64(float* q, const bf16_t* row) {
    const uint4* p = (const uint4*)row;
#pragma unroll
    for (int c = 0; c < 8; ++c) { const uint4 w = p[c]; q[8 * c + 0] = bflo(w.x); q[8 * c + 1] = bfhi(w.x); q[8 * c + 2] = bflo(w.y); q[8 * c + 3] = bfhi(w.y);
        q[8 * c + 4] = bflo(w.z); q[8 * c + 5] = bfhi(w.z); q[8 * c + 6] = bflo(w.w); q[8 * c + 7] = bfhi(w.w); }
}
__device__ __forceinline__ void store64_bf16(bf16_t* dst, const float* o, float sc) {
#pragma unroll
    for (int c = 0; c < 8; ++c) { u32x4 w; w.x = pk2(o[8 * c] * sc, o[8 * c + 1] * sc); w.y = pk2(o[8 * c + 2] * sc, o[8 * c + 3] * sc); w.z = pk2(o[8 * c + 4] * sc, o[8 * c + 5] * sc); w.w = pk2(o[8 * c + 6] * sc, o[8 * c + 7] * sc);
        *(u32x4*)(dst + 8 * c) = w; }
}
__device__ __forceinline__ int opq_tid() { int t = threadIdx.x; asm volatile("" : "+v"(t)); return t; }
template <class T> __device__ __forceinline__ T* opq(T* p) { asm volatile("" : "+s"(p)); return p; }
__device__ __forceinline__ float gelu_tanh(float x) { const float u = 0.7978845608028654f * (x + 0.044715f * x * x * x); return 0.5f * x * (1.0f + tanhf(u)); }
__device__ __forceinline__ int imin(int a, int b) { return a < b ? a : b; }
__device__ __forceinline__ int imax(int a, int b) { return a > b ? a : b; }

__device__ __forceinline__ void naive_sb(const bf16_t* proj, bf16_t* mixed, int b, int h, int t0, int lane) {
    const int t = t0 + lane; const size_t row = (size_t)b * SEQ + t;
    float q[64], o[64];
    loadq64(q, proj + row * LDP + C_SBQ + h * 64);
#pragma unroll
    for (int i = 0; i < 64; ++i) o[i] = 0.f;
    float R = 0.f;
    const bf16_t* kb = proj + (size_t)b * SEQ * LDP + C_SBK + h * 64; const bf16_t* vb = proj + (size_t)b * SEQ * LDP + C_SBV + h * 64;
    for (int s = t0 + 62; s >= 0; --s) {
        const bool act = s < t;
        const float z = dotq<8>(q, kb + (size_t)s * LDP) * 0.125f;
        const float sp = fmaxf(z, 0.f) + log1pf(expf(-fabsf(z)));
        const float a = act ? expf((z - sp) + R) : 0.f;
        if (act) R -= sp;
        axpy64(o, a, vb + (size_t)s * LDP);
        if (__all(R < -104.f)) break;
    }
    store64_bf16(mixed + row * DM + 0 + h * 64, o, 1.f);
}

__device__ __forceinline__ void naive_moba(const bf16_t* proj, const float* kmean, const float* bt, bf16_t* mixed, int b, int h, int t0, int lane) {
    const int t = t0 + lane; const size_t row = (size_t)b * SEQ + t; const int own = t0 >> 8;
    float q[64], o[64];
    loadq64(q, proj + row * LDP + C_MBQ + h * 64);
    unsigned sel = 0u;
    { float g[8];
#pragma unroll
      for (int n = 0; n < 8; ++n) { const float* km = kmean + ((size_t)(b * 4 + h) * 8 + n) * 64; float a = 0.f;
#pragma unroll
          for (int d = 0; d < 64; ++d) a = fmaf(q[d], km[d], a);
          g[n] = a; }
      for (int r = 0; r < 3; ++r) { int best = -1; float bv = -3.0e38f;
#pragma unroll
          for (int n = 0; n < 8; ++n) if (n < own && !((sel >> n) & 1u) && g[n] > bv) { bv = g[n]; best = n; }
          if (best >= 0) sel |= 1u << best; } }
    const bf16_t* kb = proj + (size_t)b * SEQ * LDP + C_MBK + h * 64; const bf16_t* vb = proj + (size_t)b * SEQ * LDP + C_MBV + h * 64;
    const float* btab = bt + (0 + h) * 128;
    float m = NEG_BIG;
    for (int n = 0; n <= own; ++n) {
        const bool mine = (n == own) || ((sel >> n) & 1u);
        if (!__any(mine)) continue;
        const int s1 = (n == own) ? t0 + 63 : n * 256 + 255;
        for (int s = n * 256; s <= s1; ++s) { const bool v = mine && s <= t;
            const float sc = dotq<8>(q, kb + (size_t)s * LDP) * 0.125f + btab[imin(imax(t - s, 0), 127)];
            if (v) m = fmaxf(m, sc); } }
#pragma unroll
    for (int i = 0; i < 64; ++i) o[i] = 0.f;
    float l = 0.f;
    for (int n = 0; n <= own; ++n) {
        const bool mine = (n == own) || ((sel >> n) & 1u);
        if (!__any(mine)) continue;
        const int s1 = (n == own) ? t0 + 63 : n * 256 + 255;
        for (int s = n * 256; s <= s1; ++s) { const bool v = mine && s <= t;
            const float sc = dotq<8>(q, kb + (size_t)s * LDP) * 0.125f + btab[imin(imax(t - s, 0), 127)];
            const float e = v ? expf(sc - m) : 0.f; l += e;
            axpy64(o, e, vb + (size_t)s * LDP); } }
    store64_bf16(mixed + row * DM + 256 + h * 64, o, 1.0f / fmaxf(l, TINY));
}

__device__ __forceinline__ void naive_diff(const bf16_t* proj, const float* bt, const float* subln, float lam, float post, bf16_t* mixed, int b, int h, int t0, int lane) {
    const int t = t0 + lane; const size_t row = (size_t)b * SEQ + t;
    float q[64], o[64];
    loadq64(q, proj + row * LDP + C_DFQ + h * 64);
    const bf16_t* kb = proj + (size_t)b * SEQ * LDP + C_DFK + h * 64; const bf16_t* vb = proj + (size_t)b * SEQ * LDP + C_DFV + h * 64;
    const float* btab = bt + (8 + h) * 128; const float scale = 0.17677669529663687f;
    float m1 = NEG_BIG, m2 = NEG_BIG;
    for (int s = 0; s <= t0 + 63; ++s) { const bool v = s <= t; const float bia = btab[imin(imax(t - s, 0), 127)];
        const float s1 = dotq<4>(q, kb + (size_t)s * LDP) * scale + bia, s2 = dotq<4>(q + 32, kb + (size_t)s * LDP + 32) * scale + bia;
        if (v) { m1 = fmaxf(m1, s1); m2 = fmaxf(m2, s2); } }
    float l1 = 0.f, l2 = 0.f;
    for (int s = 0; s <= t0 + 63; ++s) { const bool v = s <= t; const float bia = btab[imin(imax(t - s, 0), 127)];
        const float s1 = dotq<4>(q, kb + (size_t)s * LDP) * scale + bia, s2 = dotq<4>(q + 32, kb + (size_t)s * LDP + 32) * scale + bia;
        if (v) { l1 += expf(s1 - m1); l2 += expf(s2 - m2); } }
    const float r1 = 1.0f / fmaxf(l1, TINY), r2 = lam / fmaxf(l2, TINY);
#pragma unroll
    for (int i = 0; i < 64; ++i) o[i] = 0.f;
    for (int s = 0; s <= t0 + 63; ++s) { const bool v = s <= t; const float bia = btab[imin(imax(t - s, 0), 127)];
        const float s1 = dotq<4>(q, kb + (size_t)s * LDP) * scale + bia, s2 = dotq<4>(q + 32, kb + (size_t)s * LDP + 32) * scale + bia;
        const float w = v ? (expf(s1 - m1) * r1 - expf(s2 - m2) * r2) : 0.f;
        axpy64(o, w, vb + (size_t)s * LDP); }
    float ss = 0.f;
#pragma unroll
    for (int i = 0; i < 64; ++i) ss = fmaf(o[i], o[i], ss);
    const float rs = post / sqrtf(ss * (1.0f / 64.0f) + 1e-6f);
#pragma unroll
    for (int i = 0; i < 64; ++i) o[i] *= subln[i];
    store64_bf16(mixed + row * DM + 768 + h * 64, o, rs);
}

__device__ __forceinline__ void axpy32(float* o, float p, const bf16_t* row) {
    const uint4* v = (const uint4*)row;
#pragma unroll
    for (int c = 0; c < 4; ++c) { const uint4 w = v[c];
        o[8 * c + 0] = fmaf(p, bflo(w.x), o[8 * c + 0]); o[8 * c + 1] = fmaf(p, bfhi(w.x), o[8 * c + 1]); o[8 * c + 2] = fmaf(p, bflo(w.y), o[8 * c + 2]); o[8 * c + 3] = fmaf(p, bfhi(w.y), o[8 * c + 3]);
        o[8 * c + 4] = fmaf(p, bflo(w.z), o[8 * c + 4]); o[8 * c + 5] = fmaf(p, bfhi(w.z), o[8 * c + 5]); o[8 * c + 6] = fmaf(p, bflo(w.w), o[8 * c + 6]); o[8 * c + 7] = fmaf(p, bfhi(w.w), o[8 * c + 7]); }
}
__device__ __forceinline__ void naive_nsa(const bf16_t* proj, const bf16_t* kc, const bf16_t* vc, const float* bt, float* tmp, bf16_t* mixed, LAS float* imp, int b, int h, int t0, int lane) {
    const int t = t0 + lane; const size_t row = (size_t)b * SEQ + t; const int own = t0 >> 6;
    const int ncv = t >= 31 ? imin(((t - 31) >> 4) + 1, N_CMP) : 0;
    const int ncw = imin(((t0 + 63 - 31) >> 4) + 1, N_CMP);
    const bf16_t* kcb = kc + (size_t)b * 128 * 64; const bf16_t* vcb = vc + (size_t)b * 128 * 64;
    float* trow = tmp + (row * 4 + h) * 64;
    float q[64];
#pragma unroll
    for (int j = 0; j < 32; ++j) imp[j * 512] = 0.f;
    float mh = NEG_BIG, rlh = 0.f;
#pragma unroll 1
    for (int hh = 0; hh < 4; ++hh) {
        loadq64(q, proj + row * LDP + C_NSQ + hh * 64);
        const float* btab = bt + (4 + hh) * 128;
        float m = NEG_BIG;
#pragma unroll 1
        for (int c = 0; c < ncw; ++c) { const float sc = dotq<8>(q, kcb + c * 64) * 0.125f + btab[imin(imax(t - (16 * c + 31), 0), 127)]; if (c < ncv) m = fmaxf(m, sc); }
        float l = 0.f;
#pragma unroll 1
        for (int c = 0; c < ncw; ++c) { const float sc = dotq<8>(q, kcb + c * 64) * 0.125f + btab[imin(imax(t - (16 * c + 31), 0), 127)]; if (c < ncv) l += expf(sc - m); }
        const float rl = 1.0f / fmaxf(l, TINY);
        if (hh == h) { mh = m; rlh = rl; }
#pragma unroll 1
        for (int c = 0; c < ncw; ++c) { const float sc = dotq<8>(q, kcb + c * 64) * 0.125f + btab[imin(imax(t - (16 * c + 31), 0), 127)];
            const float p = (c < ncv) ? expf(sc - m) * rl : 0.f;
            const int j = c >> 2;
            if ((c & 3) == 3) { imp[j * 512] += 0.5f * p; if (j + 1 < 32) imp[(j + 1) * 512] += 0.5f * p; } else imp[j * 512] += p; }
    }
    unsigned sel = 1u << own;
    for (int r = 0; r < 3; ++r) { int best = -1; float bv = -3.0e38f;
        for (int j = 0; j < own; ++j) { const float v = imp[j * 512]; if (!((sel >> j) & 1u) && v > bv) { bv = v; best = j; } }
        if (best >= 0) sel |= 1u << best; }
    loadq64(q, proj + row * LDP + C_NSQ + h * 64);
    const float* btab = bt + (4 + h) * 128;
    const bf16_t* grow = proj + row * LDP + C_NSG;
    const float g0 = 1.0f / (1.0f + expf(-__uint_as_float((unsigned)grow[0 * 4 + h] << 16))), g1 = 1.0f / (1.0f + expf(-__uint_as_float((unsigned)grow[1 * 4 + h] << 16))),
                g2 = 1.0f / (1.0f + expf(-__uint_as_float((unsigned)grow[2 * 4 + h] << 16)));
    const bf16_t* ksb = proj + (size_t)b * SEQ * LDP + C_NKS; const bf16_t* vsb = proj + (size_t)b * SEQ * LDP + C_NVS;
    const bf16_t* kwb = proj + (size_t)b * SEQ * LDP + C_NKW; const bf16_t* vwb = proj + (size_t)b * SEQ * LDP + C_NVW;
    float ms = NEG_BIG, ls = 0.f, mw = NEG_BIG, lw = 0.f;
#pragma unroll 1
    for (int j = 0; j <= own; ++j) { const bool mine = (sel >> j) & 1u; if (!__any(mine)) continue;
#pragma unroll 1
        for (int s = j * 64; s < j * 64 + 64; ++s) { const float sc = dotq<8>(q, ksb + (size_t)s * LDP) * 0.125f + btab[imin(imax(t - s, 0), 127)]; if (mine && s <= t) ms = fmaxf(ms, sc); } }
#pragma unroll 1
    for (int j = 0; j <= own; ++j) { const bool mine = (sel >> j) & 1u; if (!__any(mine)) continue;
#pragma unroll 1
        for (int s = j * 64; s < j * 64 + 64; ++s) { const float sc = dotq<8>(q, ksb + (size_t)s * LDP) * 0.125f + btab[imin(imax(t - s, 0), 127)]; if (mine && s <= t) ls += expf(sc - ms); } }
    const int sw0 = imax(t0 - 511, 0);
#pragma unroll 1
    for (int s = sw0; s <= t0 + 63; ++s) { const float sc = dotq<8>(q, kwb + (size_t)s * LDP) * 0.125f + btab[imin(imax(t - s, 0), 127)]; if (s <= t && t - s < 512) mw = fmaxf(mw, sc); }
#pragma unroll 1
    for (int s = sw0; s <= t0 + 63; ++s) { const float sc = dotq<8>(q, kwb + (size_t)s * LDP) * 0.125f + btab[imin(imax(t - s, 0), 127)]; if (s <= t && t - s < 512) lw += expf(sc - mw); }
    const float rs = g1 / fmaxf(ls, TINY), rw = g2 / fmaxf(lw, TINY), rc = g0 * rlh;
#pragma unroll 1
    for (int half = 0; half < 2; ++half) {
        float o[32];
#pragma unroll
        for (int i = 0; i < 32; ++i) o[i] = 0.f;
#pragma unroll 1
        for (int c = 0; c < ncw; ++c) { const float sc = dotq<8>(q, kcb + c * 64) * 0.125f + btab[imin(imax(t - (16 * c + 31), 0), 127)];
            const float p = (c < ncv) ? expf(sc - mh) * rc : 0.f; axpy32(o, p, vcb + c * 64 + half * 32); }
#pragma unroll 1
        for (int j = 0; j <= own; ++j) { const bool mine = (sel >> j) & 1u; if (!__any(mine)) continue;
#pragma unroll 1
            for (int s = j * 64; s < j * 64 + 64; ++s) { const float sc = dotq<8>(q, ksb + (size_t)s * LDP) * 0.125f + btab[imin(imax(t - s, 0), 127)];
                const float e = (mine && s <= t) ? expf(sc - ms) * rs : 0.f; axpy32(o, e, vsb + (size_t)s * LDP + half * 32); } }
#pragma unroll 1
        for (int s = sw0; s <= t0 + 63; ++s) { const float sc = dotq<8>(q, kwb + (size_t)s * LDP) * 0.125f + btab[imin(imax(t - s, 0), 127)];
            const float e = (s <= t && t - s < 512) ? expf(sc - mw) * rw : 0.f; axpy32(o, e, vwb + (size_t)s * LDP + half * 32); }
        bf16_t* dst = mixed + row * DM + 512 + h * 64 + half * 32;
#pragma unroll
        for (int c = 0; c < 4; ++c) { u32x4 w; w.x = pk2(o[8 * c], o[8 * c + 1]); w.y = pk2(o[8 * c + 2], o[8 * c + 3]); w.z = pk2(o[8 * c + 4], o[8 * c + 5]); w.w = pk2(o[8 * c + 6], o[8 * c + 7]);
            *(u32x4*)(dst + 8 * c) = w; }
    }
    (void)trow;
}

namespace at {
typedef short bf16x8 __attribute__((ext_vector_type(8)));
typedef short s16x4 __attribute__((ext_vector_type(4)));
typedef float f32x16 __attribute__((ext_vector_type(16)));
constexpr int NSLOT = 5, SLOT_B = 16384, SLOT_V = 8192;
constexpr int L_BIAS = NSLOT * SLOT_B;
constexpr int BEXT = 288;
constexpr int L_MISC = L_BIAS + 2 * 12 * BEXT * 4;
constexpr float LOG2E = 1.4426950408889634f;
#define MFMA32(a, b, c) __builtin_amdgcn_mfma_f32_32x32x16_bf16((a), (b), (c), 0, 0, 0)
__device__ __forceinline__ int crow(int i, int hi) { return (i & 3) + 8 * (i >> 2) + 4 * hi; }
__device__ __forceinline__ s16x4 vtr(const LAS unsigned char* p) { typedef short v4i16_t __attribute__((ext_vector_type(4))); return __builtin_bit_cast(s16x4, __builtin_amdgcn_ds_read_tr16_b64_v4i16((LAS v4i16_t*)p)); }
__device__ __forceinline__ unsigned cvtpk(float lo, float hi) { typedef float f2 __attribute__((ext_vector_type(2))); typedef __bf16 b2 __attribute__((ext_vector_type(2))); f2 v = {lo, hi}; b2 b = __builtin_convertvector(v, b2); return __builtin_bit_cast(unsigned, b); }
__device__ __forceinline__ bf16x8 pack8(const f32x16& p, int s) { u32x4 w; w.x = cvtpk(p[8 * s], p[8 * s + 1]); w.y = cvtpk(p[8 * s + 2], p[8 * s + 3]); w.z = cvtpk(p[8 * s + 4], p[8 * s + 5]); w.w = cvtpk(p[8 * s + 6], p[8 * s + 7]); return __builtin_bit_cast(bf16x8, w); }
__device__ __forceinline__ float xhalf(float v) { return __shfl_xor(v, 32); }
__device__ __forceinline__ void glds16(const void* gsrc, unsigned lds_dst) { unsigned keep;
    asm volatile("s_mov_b32 %0, m0\n\ts_mov_b32 m0, %2\n\ts_nop 0\n\tglobal_load_lds_dwordx4 %1, off\n\ts_mov_b32 m0, %0" : "=&s"(keep) : "v"(gsrc), "s"(lds_dst) : "memory"); }
template <int PITCH = LDP> __device__ __forceinline__ void dma_tile(const bf16_t* kbase, const bf16_t* vbase, int s0, LAS unsigned char* lds, int slot, int wave, int lane) {
    const unsigned dst = (unsigned)(uintptr_t)lds + (unsigned)(slot * SLOT_B + wave * 1024);
    glds16(kbase + (size_t)(s0 + lane) * PITCH + wave * 8, (unsigned)__builtin_amdgcn_readfirstlane((int)dst));
    glds16(vbase + (size_t)(s0 + 16 * (wave & 3) + (lane >> 2)) * PITCH + (wave >> 2) * 32 + (lane & 3) * 8, (unsigned)__builtin_amdgcn_readfirstlane((int)(dst + SLOT_V)));
}
#define WAIT_BAR(N) asm volatile("s_waitcnt vmcnt(" #N ") lgkmcnt(0)\n\ts_barrier" ::: "memory")
#define END_STEP3(i, n) do { if ((i) + 3 < (n)) WAIT_BAR(4); else if ((i) + 2 < (n)) WAIT_BAR(2); else WAIT_BAR(0); } while (0)
#define END_STEP(i, n) do { if ((i) + 4 < (n)) WAIT_BAR(4); else if ((i) + 3 < (n)) WAIT_BAR(2); else WAIT_BAR(0); } while (0)
template <int D0, int ND> __device__ __forceinline__ void qk(f32x16& p0, f32x16& p1, const LAS unsigned char* kb, const bf16x8 (&q)[4], int lane) {
    const LAS unsigned char* a = kb + (lane >> 5) * 1024 + (lane & 31) * 16;
    constexpr int NB = ND > 2 ? 2 : ND;
#pragma unroll
    for (int d1 = 0; d1 < ND; d1 += NB) {
        bf16x8 kf[2 * NB];
#pragma unroll
        for (int d = 0; d < NB; ++d) { kf[2 * d] = *(const LAS bf16x8*)(a + (D0 + d1 + d) * 2048); kf[2 * d + 1] = *(const LAS bf16x8*)(a + (D0 + d1 + d) * 2048 + 512); }
        __builtin_amdgcn_sched_barrier(0);
#pragma unroll
        for (int d = 0; d < NB; ++d) { p0 = MFMA32(kf[2 * d], q[D0 + d1 + d], p0); p1 = MFMA32(kf[2 * d + 1], q[D0 + d1 + d], p1); }
    }
}
__device__ __forceinline__ void pv(f32x16 (&o)[2], const LAS unsigned char* vb, const bf16x8 (&pk)[4], int lane) {
    const int i16 = lane & 15, hi = lane >> 5;
    const LAS unsigned char* base = vb + (4 * hi + (i16 >> 2)) * 64 + ((lane >> 4) & 1) * 32 + (i16 & 3) * 8;
#pragma unroll
    for (int half = 0; half < 2; ++half) {
        s16x4 lo[4], hh[4];
#pragma unroll
        for (int s2 = 0; s2 < 2; ++s2)
#pragma unroll
            for (int db = 0; db < 2; ++db) { const int s = 2 * half + s2; lo[2 * s2 + db] = vtr(base + db * 4096 + s * 1024); hh[2 * s2 + db] = vtr(base + db * 4096 + s * 1024 + 512); }
        __builtin_amdgcn_sched_barrier(0);
#pragma unroll
        for (int s2 = 0; s2 < 2; ++s2)
#pragma unroll
            for (int db = 0; db < 2; ++db) { const s16x4 l = lo[2 * s2 + db], h = hh[2 * s2 + db];
                const bf16x8 vf = {l[0], l[1], l[2], l[3], h[0], h[1], h[2], h[3]};
                o[db] = MFMA32(vf, pk[2 * half + s2], o[db]); }
    }
}
__device__ __forceinline__ void osm(f32x16& p0, f32x16& p1, float& m, float& l, f32x16 (&o)[2]) {
    float mx = fmaxf(p0[0], p1[0]);
#pragma unroll
    for (int i = 1; i < 16; ++i) mx = fmaxf(mx, fmaxf(p0[i], p1[i]));
    mx = fmaxf(mx, xhalf(mx));
    const float mn = fmaxf(m, mx);
    if (__any(mn > m)) { const float al = __builtin_amdgcn_exp2f(m - mn); l *= al;
#pragma unroll
        for (int i = 0; i < 16; ++i) { o[0][i] *= al; o[1][i] *= al; }
        m = mn; }
    float s = 0.f;
#pragma unroll
    for (int i = 0; i < 16; ++i) { p0[i] = __builtin_amdgcn_exp2f(p0[i] - m); p1[i] = __builtin_amdgcn_exp2f(p1[i] - m); s += p0[i] + p1[i]; }
    l += s;
}
template <bool CAUSAL> __device__ __forceinline__ void bias_mask(f32x16& p0, f32x16& p1, float c2, const LAS float* b2e, int tq, int s0, int hi, bool near, bool diag) {
    if (!near) { const float bc = b2e[64 + 127];
#pragma unroll
        for (int i = 0; i < 16; ++i) { p0[i] = fmaf(p0[i], c2, bc); p1[i] = fmaf(p1[i], c2, bc); }
    } else {
        const int rel = tq - s0 - 4 * hi;
        const LAS float* bp = b2e + (rel + 64 - 63);
#pragma unroll
        for (int i = 0; i < 16; ++i) { const int k0 = (i & 3) + 8 * (i >> 2);
            p0[i] = fmaf(p0[i], c2, bp[63 - k0]); p1[i] = fmaf(p1[i], c2, bp[63 - k0 - 32]); }
        if (CAUSAL && diag) {
#pragma unroll
            for (int i = 0; i < 16; ++i) { const int k0 = (i & 3) + 8 * (i >> 2);
                if (rel < k0) p0[i] = -INFINITY; if (rel < k0 + 32) p1[i] = -INFINITY; } }
    }
}

constexpr float SM_THR = 8.0f;
__device__ __forceinline__ float max32(const f32x16& p0, const f32x16& p1) {
    float a = fmaxf(fmaxf(p0[0], p0[1]), p1[0]), b = fmaxf(fmaxf(p0[2], p0[3]), p1[1]); a = fmaxf(fmaxf(a, p1[2]), p1[3]);
#pragma unroll
    for (int r = 4; r < 16; r += 4) { a = fmaxf(fmaxf(a, p0[r]), p0[r + 1]); b = fmaxf(fmaxf(b, p0[r + 2]), p0[r + 3]); a = fmaxf(fmaxf(a, p1[r]), p1[r + 1]); b = fmaxf(fmaxf(b, p1[r + 2]), p1[r + 3]); }
    return fmaxf(a, b);
}
template <bool LANEMASK, bool LOWER> __device__ __forceinline__ void soft(f32x16& p0, f32x16& p1, float c2, const LAS float* b2e, int rel, bool near, bool diag, bool mine, bool low, int r1,
                                                                          float& m, float& l, f32x16 (&o)[2]) {
    const float bc = b2e[64 + 127];
    if (near) {
        const LAS float* bp = b2e + 12 * BEXT + (rel + 64 - 63);
#pragma unroll
        for (int i = 0; i < 16; ++i) { const int k0 = (i & 3) + 8 * (i >> 2); p0[i] += bp[63 - k0]; p1[i] += bp[63 - k0 - 32]; }
        if (diag) {
#pragma unroll
            for (int i = 0; i < 16; ++i) { const int k0 = (i & 3) + 8 * (i >> 2); if (rel < k0) p0[i] = -INFINITY; if (rel < k0 + 32) p1[i] = -INFINITY; } }
    }
    if (LOWER && low) {
#pragma unroll
        for (int i = 0; i < 16; ++i) { const int k0 = (i & 3) + 8 * (i >> 2); if (k0 < r1) p0[i] = -INFINITY; if (k0 + 32 < r1) p1[i] = -INFINITY; } }
    float tm = max32(p0, p1); tm = fmaxf(tm, xhalf(tm)); tm = fmaf(tm, c2, bc);
    if (LANEMASK && !mine) tm = -INFINITY;
    const float mn = tm > m + SM_THR ? tm : m, al = __builtin_amdgcn_exp2f(m - mn);
    m = mn; l *= al;
#pragma unroll
    for (int i = 0; i < 16; ++i) { o[0][i] *= al; o[1][i] *= al; }
    float off = bc - m; if (LANEMASK && !mine) off = -INFINITY;
    float s = 0.f;
#pragma unroll
    for (int i = 0; i < 16; ++i) { p0[i] = __builtin_amdgcn_exp2f(fmaf(p0[i], c2, off)); p1[i] = __builtin_amdgcn_exp2f(fmaf(p1[i], c2, off)); s += p0[i] + p1[i]; }
    l += s;
}
template <int D0, int ND> __device__ __forceinline__ void qk_issue(f32x16& p0, f32x16& p1, const LAS unsigned char* kb, const bf16x8 (&q)[4], int lane) {
#pragma unroll
    for (int i = 0; i < 16; ++i) { p0[i] = 0.f; p1[i] = 0.f; }
    qk<D0, ND>(p0, p1, kb, q, lane);
}
#define SOFT_PV(LM, LW, P0, P1, VB, O, M, L, NEAR, DIAG, MINE, LOW, R1) do { soft<LM, LW>(P0, P1, c2, b2, tq - s0_ - 4 * hi, NEAR, DIAG, MINE, LOW, R1, M, L, O); \
    bf16x8 pk_[4] = {pack8(P0, 0), pack8(P0, 1), pack8(P1, 0), pack8(P1, 1)}; pv(O, VB, pk_, lane); } while (0)

template <int D0, int ND, bool LM> __device__ __forceinline__ void causal_pass(const bf16_t* kbase, const bf16_t* vbase, LAS unsigned char* lds, const bf16x8 (&q)[4], float c2, const LAS float* b2,
        int tq, int tq0, int hi, int lane, int wave, int nt, int own, unsigned sel, float& m, float& l, f32x16 (&o)[2]) {
#pragma unroll
    for (int k = 0; k < 4; ++k) if (k < nt) dma_tile(kbase, vbase, 64 * k, lds, k, wave, lane);
    END_STEP(-1, nt);
    f32x16 sc0, sc1;
    int sl = 0, sl4 = 4;
    for (int j = 0; j < nt; ++j) {
        const LAS unsigned char* vb = lds + sl * SLOT_B + SLOT_V; const int sn = sl == NSLOT - 1 ? 0 : sl + 1;
        if (j + 4 < nt) dma_tile(kbase, vbase, 64 * (j + 4), lds, sl4, wave, lane);
        for (int rep = 0; rep < 2; ++rep) {
          qk_issue<D0, ND>(sc0, sc1, lds + sl * SLOT_B, q, lane); __builtin_amdgcn_sched_barrier(0);
          const int s0_ = 64 * j, nb = j >> 2; const bool mine = nb >= own || ((sel >> nb) & 1u);
          SOFT_PV(LM, false, sc0, sc1, vb, o, m, l, (tq0 - (s0_ + 63)) < 113, (s0_ + 63) > tq0, mine, false, 0); __builtin_amdgcn_sched_barrier(0); }
        END_STEP(j, nt);
        sl = sn; sl4 = sl4 == NSLOT - 1 ? 0 : sl4 + 1; }
}

__device__ __forceinline__ void diff_unit(const bf16_t* proj, const float* subln, float lam, float post, bf16_t* mixed, LAS unsigned char* lds, int b, int h, int qb) {
    const int tid = opq_tid(), lane = tid & 63, wave = __builtin_amdgcn_readfirstlane(tid >> 6), hi = lane >> 5;
    const int tq0 = qb * 256 + wave * 32, tq = tq0 + (lane & 31);
    const bf16_t* kbase = proj + (size_t)b * SEQ * LDP + C_DFK + h * 64; const bf16_t* vbase = proj + (size_t)b * SEQ * LDP + C_DFV + h * 64;
    const LAS float* b2 = (const LAS float*)(lds + L_BIAS) + (8 + h) * BEXT;
    bf16x8 q[4];
    { const bf16_t* qrow = proj + ((size_t)b * SEQ + tq) * LDP + C_DFQ + h * 64 + hi * 8;
#pragma unroll
      for (int d0 = 0; d0 < 4; ++d0) q[d0] = *(const bf16x8*)(qrow + d0 * 16); }
    const float c2 = 0.17677669529663687f * LOG2E;
    float m1 = -1e30f, m2 = -1e30f, l1 = 0.f, l2 = 0.f; f32x16 o1[2], o2[2];
#pragma unroll
    for (int i = 0; i < 16; ++i) { o1[0][i] = 0.f; o1[1][i] = 0.f; o2[0][i] = 0.f; o2[1][i] = 0.f; }
    causal_pass<0, 2, false>(kbase, vbase, lds, q, c2, b2, tq, tq0, hi, lane, wave, 4 * (qb + 1), 0, 0u, m1, l1, o1);
    l1 += xhalf(l1);
    { const float r1 = 1.0f / fmaxf(l1, TINY);
#pragma unroll
      for (int i = 0; i < 16; ++i) { o1[0][i] *= r1; o1[1][i] *= r1; } }
    causal_pass<2, 2, false>(kbase, vbase, lds, q, c2, b2, tq, tq0, hi, lane, wave, 4 * (qb + 1), 0, 0u, m2, l2, o2);
    l2 += xhalf(l2);
    const float r1 = 1.0f, r2 = lam / fmaxf(l2, TINY);
    float ss = 0.f;
#pragma unroll
    for (int db = 0; db < 2; ++db)
#pragma unroll
        for (int i = 0; i < 16; ++i) { const float v = o1[db][i] * r1 - o2[db][i] * r2; o1[db][i] = v; ss = fmaf(v, v, ss); }
    ss += xhalf(ss);
    const float rs = post / sqrtf(ss * (1.0f / 64.0f) + 1e-6f);
    bf16_t* orow = mixed + ((size_t)b * SEQ + tq) * DM + 768 + h * 64;
#pragma unroll
    for (int db = 0; db < 2; ++db)
#pragma unroll
        for (int g = 0; g < 4; ++g) { const int d = 32 * db + 8 * g + 4 * hi; const f32x4 gn = *(const f32x4*)(subln + d);
            uint2 w; w.x = pk2(o1[db][4 * g] * rs * gn[0], o1[db][4 * g + 1] * rs * gn[1]); w.y = pk2(o1[db][4 * g + 2] * rs * gn[2], o1[db][4 * g + 3] * rs * gn[3]);
            *(uint2*)(orow + d) = w; }
}

__device__ __forceinline__ void store_ot(bf16_t* orow, const f32x16 (&o)[2], float sc, int hi) {
#pragma unroll
    for (int db = 0; db < 2; ++db)
#pragma unroll
        for (int g = 0; g < 4; ++g) { uint2 w; w.x = pk2(o[db][4 * g] * sc, o[db][4 * g + 1] * sc); w.y = pk2(o[db][4 * g + 2] * sc, o[db][4 * g + 3] * sc);
            *(uint2*)(orow + 32 * db + 8 * g + 4 * hi) = w; }
}

__device__ __forceinline__ void moba_unit(const bf16_t* proj, const float* kmean, bf16_t* mixed, LAS unsigned char* lds, int b, int h, int own) {
    const int tid = opq_tid(), lane = tid & 63, wave = __builtin_amdgcn_readfirstlane(tid >> 6), hi = lane >> 5;
    const int tq0 = own * 256 + wave * 32, tq = tq0 + (lane & 31);
    const bf16_t* kbase = proj + (size_t)b * SEQ * LDP + C_MBK + h * 64; const bf16_t* vbase = proj + (size_t)b * SEQ * LDP + C_MBV + h * 64;
    const LAS float* b2 = (const LAS float*)(lds + L_BIAS) + (0 + h) * BEXT;
    bf16x8 q[4];
    { const bf16_t* qrow = proj + ((size_t)b * SEQ + tq) * LDP + C_MBQ + h * 64 + hi * 8;
#pragma unroll
      for (int d0 = 0; d0 < 4; ++d0) q[d0] = *(const bf16x8*)(qrow + d0 * 16); }
    unsigned sel = 0u;
    { float g[7];
#pragma unroll
      for (int n = 0; n < 7; ++n) { float a = 0.f;
          if (n < own) { const float* km = kmean + ((size_t)(b * 4 + h) * 8 + n) * 64 + hi * 8;
#pragma unroll
              for (int d0 = 0; d0 < 4; ++d0) { const f32x4 k0 = *(const f32x4*)(km + d0 * 16), k1 = *(const f32x4*)(km + d0 * 16 + 4); const u32x4 qw = __builtin_bit_cast(u32x4, q[d0]);
                  a = fmaf(bflo(qw.x), k0[0], a); a = fmaf(bfhi(qw.x), k0[1], a); a = fmaf(bflo(qw.y), k0[2], a); a = fmaf(bfhi(qw.y), k0[3], a);
                  a = fmaf(bflo(qw.z), k1[0], a); a = fmaf(bfhi(qw.z), k1[1], a); a = fmaf(bflo(qw.w), k1[2], a); a = fmaf(bfhi(qw.w), k1[3], a); } }
          g[n] = a + xhalf(a); }
#pragma unroll
      for (int r = 0; r < 3; ++r) { int best = -1; float bv = -3.0e38f;
#pragma unroll
          for (int n = 0; n < 7; ++n) if (n < own && !((sel >> n) & 1u) && g[n] > bv) { bv = g[n]; best = n; }
          if (best >= 0) sel |= 1u << best; } }
    const float c2 = 0.125f * LOG2E;
    float m = -1e30f, l = 0.f; f32x16 o[2];
#pragma unroll
    for (int i = 0; i < 16; ++i) { o[0][i] = 0.f; o[1][i] = 0.f; }
    causal_pass<0, 4, true>(kbase, vbase, lds, q, c2, b2, tq, tq0, hi, lane, wave, 4 * (own + 1), own, sel, m, l, o);
    l += xhalf(l);
    store_ot(mixed + ((size_t)b * SEQ + tq) * DM + 256 + h * 64, o, 1.0f / fmaxf(l, TINY), hi);
}

constexpr int L_IMP = L_MISC, L_WM = L_IMP + 4 * 64 * 33 * 4, L_NSA_END = L_WM + 64;
__device__ __forceinline__ void nsa_unit(const bf16_t* proj, const bf16_t* kc, const bf16_t* vc, bf16_t* mixed, LAS unsigned char* lds, int b, int own) {
    const int tid = opq_tid(), lane = tid & 63, wave = __builtin_amdgcn_readfirstlane(tid >> 6), hi = lane >> 5, hd = wave >> 1, qs = wave & 1;
    const int t0 = own * 64, tq0 = t0 + qs * 32, ql = qs * 32 + (lane & 31), tq = t0 + ql;
    const LAS float* b2 = (const LAS float*)(lds + L_BIAS) + (4 + hd) * BEXT;
    LAS float* IMP = (LAS float*)(lds + L_IMP); LAS unsigned* WM = (LAS unsigned*)(lds + L_WM);
    const size_t rowq = (size_t)b * SEQ + tq;
    bf16x8 q[4];
    { const bf16_t* qrow = proj + rowq * LDP + C_NSQ + hd * 64 + hi * 8;
#pragma unroll
      for (int d0 = 0; d0 < 4; ++d0) q[d0] = *(const bf16x8*)(qrow + d0 * 16); }
    const float c2 = 0.125f * LOG2E;
    f32x16 acc[2];
    {
        const bf16_t* kcb = kc + (size_t)b * 128 * 64; const bf16_t* vcb = vc + (size_t)b * 128 * 64;
        const bool two = (imin(((t0 + 32) >> 4) + 1, N_CMP)) > 64;
        dma_tile<64>(kcb, vcb, 0, lds, 0, wave, lane);
        if (two) dma_tile<64>(kcb, vcb, 64, lds, 1, wave, lane);
        WAIT_BAR(0);
        f32x16 p[4];
#pragma unroll
        for (int e = 0; e < 4; ++e)
#pragma unroll
            for (int i = 0; i < 16; ++i) p[e][i] = 0.f;
        qk<0, 4>(p[0], p[1], lds, q, lane);
        if (two) qk<0, 4>(p[2], p[3], lds + SLOT_B, q, lane);
        float mx = -INFINITY;
#pragma unroll
        for (int e = 0; e < 4; ++e)
#pragma unroll
            for (int i = 0; i < 16; ++i) { const int c = 32 * e + crow(i, hi), dist = tq - 31 - 16 * c;
                const float v = dist >= 0 ? fmaf(p[e][i], c2, b2[64 + imin(imax(dist, 0), 127)]) : -INFINITY; p[e][i] = v; mx = fmaxf(mx, v); }
        mx = fmaxf(mx, xhalf(mx)); const float ms = (mx == -INFINITY) ? 0.f : mx;
        float sum = 0.f;
#pragma unroll
        for (int e = 0; e < 4; ++e)
#pragma unroll
            for (int i = 0; i < 16; ++i) { p[e][i] = __builtin_amdgcn_exp2f(p[e][i] - ms); sum += p[e][i]; }
        sum += xhalf(sum); const float rl = 1.0f / fmaxf(sum, TINY);
#pragma unroll
        for (int e = 0; e < 4; ++e)
#pragma unroll
            for (int i = 0; i < 16; ++i) p[e][i] *= rl;
#pragma unroll
        for (int i = 0; i < 16; ++i) { acc[0][i] = 0.f; acc[1][i] = 0.f; }
        { bf16x8 pk[4] = {pack8(p[0], 0), pack8(p[0], 1), pack8(p[1], 0), pack8(p[1], 1)}; pv(acc, lds + SLOT_V, pk, lane); }
        if (two) { bf16x8 pk[4] = {pack8(p[2], 0), pack8(p[2], 1), pack8(p[3], 0), pack8(p[3], 1)}; pv(acc, lds + SLOT_B + SLOT_V, pk, lane); }
        float part[16], sp[16];
#pragma unroll
        for (int e = 0; e < 16; ++e) { const f32x16& P = p[e >> 2]; const int m4 = e & 3; sp[e] = 0.5f * P[4 * m4 + 3]; part[e] = (P[4 * m4] + P[4 * m4 + 1]) + (P[4 * m4 + 2] + sp[e]); }
        LAS float* irow = IMP + (hd * 64 + ql) * 33 + hi;
        float prev = 0.f;
#pragma unroll
        for (int e = 0; e < 16; ++e) { const float xo = xhalf(sp[e]); const float recv = hi ? xo : prev; prev = xo; irow[2 * e] = part[e] + recv; }
        const float g0 = 1.0f / (1.0f + __expf(-__uint_as_float((unsigned)proj[rowq * LDP + C_NSG + 0 * 4 + hd] << 16)));
#pragma unroll
        for (int i = 0; i < 16; ++i) { acc[0][i] *= g0; acc[1][i] *= g0; }
    }
    __syncthreads();
    unsigned sel = 1u << own;
    { float v1 = -3.0e38f, v2 = -3.0e38f, v3 = -3.0e38f; int i1 = -1, i2 = -1, i3 = -1;
      const LAS float* ir = IMP + ql * 33;
#pragma unroll 1
      for (int j = 0; j < own; ++j) { const float v = ((ir[j] + ir[64 * 33 + j]) + ir[2 * 64 * 33 + j]) + ir[3 * 64 * 33 + j];
          if (v > v1) { v3 = v2; i3 = i2; v2 = v1; i2 = i1; v1 = v; i1 = j; } else if (v > v2) { v3 = v2; i3 = i2; v2 = v; i2 = j; } else if (v > v3) { v3 = v; i3 = j; } }
      if (i1 >= 0) sel |= 1u << i1; if (i2 >= 0) sel |= 1u << i2; if (i3 >= 0) sel |= 1u << i3; }
    unsigned bm;
    { unsigned wm = sel;
#pragma unroll
      for (int o = 1; o < 64; o <<= 1) wm |= (unsigned)__shfl_xor((int)wm, o);
      if (lane == 0) WM[wave] = wm;
      __syncthreads();
      bm = WM[0] | WM[1] | WM[2] | WM[3] | WM[4] | WM[5] | WM[6] | WM[7]; }
#pragma unroll 1
    for (int br = 1; br <= 2; ++br) {
        const bf16_t* kbase = proj + (size_t)b * SEQ * LDP + (br == 1 ? C_NKS : C_NKW); const bf16_t* vbase = proj + (size_t)b * SEQ * LDP + (br == 1 ? C_NVS : C_NVW);
        unsigned rem = br == 1 ? bm : (((own >= 8 ? 0x1ffu << (own - 8) : 0x1ffu >> (8 - own))) & ((2u << own) - 1u));
        float m = -1e30f, l = 0.f; f32x16 o[2];
#pragma unroll
        for (int i = 0; i < 16; ++i) { o[0][i] = 0.f; o[1][i] = 0.f; }
        const int n = __popc(rem); unsigned iss = rem;
#pragma unroll
        for (int k = 0; k < 4; ++k) if (iss) { const int t = __ffs((int)iss) - 1; iss &= iss - 1u; dma_tile(kbase, vbase, 64 * t, lds, k, wave, lane); }
        END_STEP(-1, n);
        f32x16 sc0, sc1, sn0, sn1;
        int jc = __ffs((int)rem) - 1; rem &= rem - 1u;
        qk_issue<0, 4>(sc0, sc1, lds, q, lane);
        int sl = 0, sl4 = 4;
#define NS_STEP(C0, C1, N0, N1, i) do { \
            const LAS unsigned char* vb = lds + sl * SLOT_B + SLOT_V; const int sn = sl == NSLOT - 1 ? 0 : sl + 1; \
            if (iss) { const int t = __ffs((int)iss) - 1; iss &= iss - 1u; dma_tile(kbase, vbase, 64 * t, lds, sl4, wave, lane); } \
            const int jn = rem ? __ffs((int)rem) - 1 : -1; rem &= rem - 1u; \
            qk_issue<0, 4>(N0, N1, lds + (jn >= 0 ? sn : sl) * SLOT_B, q, lane); __builtin_amdgcn_sched_barrier(0); \
            { const int s0_ = 64 * jc; const bool mine = br == 2 || ((sel >> jc) & 1u); \
              SOFT_PV(true, true, C0, C1, vb, o, m, l, (tq0 - (s0_ + 63)) < 113, jc == own, mine, br == 2 && jc == own - 8, ql + 1 - 4 * hi); __builtin_amdgcn_sched_barrier(0); } \
            END_STEP(i, n); \
            jc = jn; sl = sn; sl4 = sl4 == NSLOT - 1 ? 0 : sl4 + 1; } while (0)
        for (int i = 0; i < n; i += 2) { NS_STEP(sc0, sc1, sn0, sn1, i); if (i + 1 < n) NS_STEP(sn0, sn1, sc0, sc1, i + 1); }
#undef NS_STEP
        l += xhalf(l);
        const float g = 1.0f / (1.0f + __expf(-__uint_as_float((unsigned)proj[rowq * LDP + C_NSG + br * 4 + hd] << 16))) / fmaxf(l, TINY);
#pragma unroll
        for (int i = 0; i < 16; ++i) { acc[0][i] = fmaf(o[0][i], g, acc[0][i]); acc[1][i] = fmaf(o[1][i], g, acc[1][i]); }
    }
    store_ot(mixed + rowq * DM + 512 + hd * 64, acc, 1.0f, hi);
}

constexpr int L_DONE = L_MISC;
__device__ __forceinline__ void sb_unit(const bf16_t* proj, bf16_t* mixed, LAS unsigned char* lds, int b, int h, int qb) {
    const int tid = opq_tid(), lane = tid & 63, wave = __builtin_amdgcn_readfirstlane(tid >> 6), hi = lane >> 5;
    const int tq0 = qb * 256 + wave * 32, tq = tq0 + (lane & 31);
    const bf16_t* kbase = proj + (size_t)b * SEQ * LDP + C_SBK + h * 64; const bf16_t* vbase = proj + (size_t)b * SEQ * LDP + C_SBV + h * 64;
    LAS unsigned* DONE = (LAS unsigned*)(lds + L_DONE);
    bf16x8 q[4];
    { const bf16_t* qrow = proj + ((size_t)b * SEQ + tq) * LDP + C_SBQ + h * 64 + hi * 8;
#pragma unroll
      for (int d0 = 0; d0 < 4; ++d0) q[d0] = *(const bf16x8*)(qrow + d0 * 16); }
    float R = 0.f; f32x16 o[2];
#pragma unroll
    for (int i = 0; i < 16; ++i) { o[0][i] = 0.f; o[1][i] = 0.f; }
    const int jtop = 4 * qb + 3, jw = 4 * qb + (wave >> 1);
    bool wdone = false;
    const int nt = jtop + 1;
#pragma unroll
    for (int k = 0; k < 3; ++k) if (k < nt) dma_tile(kbase, vbase, 64 * (jtop - k), lds, k, wave, lane);
    END_STEP3(-1, nt);
    int it = 0;
    for (int j = jtop; j >= 0; --j, ++it) {
        const LAS unsigned char* kb = lds + (it & 3) * SLOT_B; const LAS unsigned char* vb = kb + SLOT_V;
        if (it + 3 < nt) dma_tile(kbase, vbase, 64 * (j - 3), lds, (it + 3) & 3, wave, lane);
        if (j <= jw && !wdone) {
            const int s0 = 64 * j;
            f32x16 p0, p1;
#pragma unroll
            for (int i = 0; i < 16; ++i) { p0[i] = 0.f; p1[i] = 0.f; }
            qk<0, 4>(p0, p1, kb, q, lane);
            const int rel = tq - s0 - 4 * hi;
            f32x16 lk0, lk1;
#pragma unroll
            for (int i = 0; i < 16; ++i) { const int k0 = (i & 3) + 8 * (i >> 2);
                const float z0 = p0[i] * 0.125f, z1 = p1[i] * 0.125f;
                const float sp0 = fmaxf(z0, 0.f) + 0.6931471805599453f * __builtin_amdgcn_logf(1.0f + __builtin_amdgcn_exp2f(-fabsf(z0) * LOG2E));
                const float sp1 = fmaxf(z1, 0.f) + 0.6931471805599453f * __builtin_amdgcn_logf(1.0f + __builtin_amdgcn_exp2f(-fabsf(z1) * LOG2E));
                const bool v0 = k0 < rel, v1 = k0 + 32 < rel;
                lk0[i] = v0 ? -sp0 : 0.f; lk1[i] = v1 ? -sp1 : 0.f;
                p0[i] = v0 ? z0 - sp0 : -INFINITY; p1[i] = v1 ? z1 - sp1 : -INFINITY; }
            float gs[8];
#pragma unroll
            for (int e = 0; e < 8; ++e) { f32x16& L = (e < 4) ? lk0 : lk1; f32x16& P = (e < 4) ? p0 : p1; const int m4 = e & 3;
                const float x0 = L[4 * m4], x1 = L[4 * m4 + 1], x2 = L[4 * m4 + 2], x3 = L[4 * m4 + 3];
                const float w2 = x3, w1 = x3 + x2, w0 = w1 + x1; gs[e] = w0 + x0;
                P[4 * m4] += w0; P[4 * m4 + 1] += w1; P[4 * m4 + 2] += w2; }
            float above = R, tot = 0.f;
#pragma unroll
            for (int e = 7; e >= 0; --e) { f32x16& P = (e < 4) ? p0 : p1; const int m4 = e & 3;
                const float xo = xhalf(gs[e]); const float ab = above + (hi ? 0.f : xo);
                P[4 * m4] += ab; P[4 * m4 + 1] += ab; P[4 * m4 + 2] += ab; P[4 * m4 + 3] += ab;
                above += gs[e] + xo; tot += gs[e] + xo; }
            R += tot;
#pragma unroll
            for (int i = 0; i < 16; ++i) { p0[i] = __builtin_amdgcn_exp2f(p0[i] * LOG2E); p1[i] = __builtin_amdgcn_exp2f(p1[i] * LOG2E); }
            bf16x8 pk[4] = {pack8(p0, 0), pack8(p0, 1), pack8(p1, 0), pack8(p1, 1)}; pv(o, vb, pk, lane);
            wdone = __all(R < -104.f);
        }
        if (lane == 0) DONE[(it & 1) * 8 + wave] = wdone ? 1u : 0u;
        END_STEP3(it, nt);
        const LAS unsigned* dn = DONE + (it & 1) * 8;
        if ((dn[0] & dn[1] & dn[2] & dn[3] & dn[4] & dn[5] & dn[6] & dn[7]) != 0u) break;
    }
    WAIT_BAR(0);
    store_ot(mixed + ((size_t)b * SEQ + tq) * DM + 0 + h * 64, o, 1.0f, hi);
}

constexpr int CA_STR = 4112, CH_STR = 528;
__device__ __forceinline__ void compress_unit(const bf16_t* proj, int col0, const float* pos, const bf16_t* w1t, const bf16_t* w2t, bf16_t* outp, LAS unsigned char* lds, int tile) {
    const int tid = opq_tid(), lane = tid & 63, wave = __builtin_amdgcn_readfirstlane(tid >> 6), hi = lane >> 5;
    {
      const int sr = tid >> 4, r = imin(tile * 32 + sr, 8 * N_CMP - 1), rb = r / N_CMP, rc = r % N_CMP, lq = (tid & 15) >> 2, dq = (tid & 3) * 16;
      const bf16_t* src = proj + ((size_t)rb * SEQ + 16 * rc + lq) * LDP + col0 + dq;
#pragma unroll 2
      for (int ch = 0; ch < 8; ++ch) {
          const u32x4 x0 = *(const u32x4*)(src + (size_t)(4 * ch) * LDP), x1 = *(const u32x4*)(src + (size_t)(4 * ch) * LDP + 8);
          const float* pp = pos + (4 * ch + lq) * 64 + dq; const f32x4 q0 = *(const f32x4*)pp, q1 = *(const f32x4*)(pp + 4), q2 = *(const f32x4*)(pp + 8), q3 = *(const f32x4*)(pp + 12);
          u32x4 y0, y1;
          y0.x = pk2(bflo(x0.x) + q0[0], bfhi(x0.x) + q0[1]); y0.y = pk2(bflo(x0.y) + q0[2], bfhi(x0.y) + q0[3]); y0.z = pk2(bflo(x0.z) + q1[0], bfhi(x0.z) + q1[1]); y0.w = pk2(bflo(x0.w) + q1[2], bfhi(x0.w) + q1[3]);
          y1.x = pk2(bflo(x1.x) + q2[0], bfhi(x1.x) + q2[1]); y1.y = pk2(bflo(x1.y) + q2[2], bfhi(x1.y) + q2[3]); y1.z = pk2(bflo(x1.z) + q3[0], bfhi(x1.z) + q3[1]); y1.w = pk2(bflo(x1.w) + q3[2], bfhi(x1.w) + q3[3]);
          LAS unsigned char* d = lds + sr * CA_STR + ((4 * ch + lq) * 64 + dq) * 2; *(LAS u32x4*)d = y0; *(LAS u32x4*)(d + 16) = y1; } }
    __syncthreads();
    f32x16 acc;
#pragma unroll
    for (int i = 0; i < 16; ++i) acc[i] = 0.f;
    { const LAS unsigned char* ap = lds + (lane & 31) * CA_STR + hi * 16; const bf16_t* bsrc = w1t + (size_t)(wave * 32 + (lane & 31)) * 2048 + hi * 8;
#pragma unroll 16
      for (int ks = 0; ks < 128; ++ks) { const bf16x8 af = *(const LAS bf16x8*)(ap + ks * 32); const bf16x8 bfr = *(const bf16x8*)(bsrc + ks * 16); acc = MFMA32(af, bfr, acc); } }
    __syncthreads();
    { const int n = wave * 32 + (lane & 31);
#pragma unroll
      for (int i = 0; i < 16; ++i) *(LAS bf16_t*)(lds + crow(i, hi) * CH_STR + n * 2) = (bf16_t)f2bf(gelu_tanh(acc[i])); }
    __syncthreads();
    if (wave < 2) {
        f32x16 o2;
#pragma unroll
        for (int i = 0; i < 16; ++i) o2[i] = 0.f;
        const LAS unsigned char* ap = lds + (lane & 31) * CH_STR + hi * 16; const bf16_t* b2p = w2t + (size_t)(wave * 32 + (lane & 31)) * 256 + hi * 8;
#pragma unroll
        for (int ks = 0; ks < 16; ++ks) { const bf16x8 af = *(const LAS bf16x8*)(ap + ks * 32); const bf16x8 bfr = *(const bf16x8*)(b2p + ks * 16); o2 = MFMA32(af, bfr, o2); }
        const int n = wave * 32 + (lane & 31);
#pragma unroll
        for (int i = 0; i < 16; ++i) { const int rr = tile * 32 + crow(i, hi); if (rr < 8 * N_CMP) outp[((size_t)(rr / N_CMP) * 128 + rr % N_CMP) * 64 + n] = (bf16_t)f2bf(o2[i]); }
    }
    __syncthreads();
}
__device__ __forceinline__ void kmean_item(const bf16_t* proj, float* kmean, int item, int lane) {
    const int n = item & 7, bh = item >> 3, b = bh >> 2, h = bh & 3;
    const bf16_t* kb = proj + ((size_t)b * SEQ + n * 256 + (lane >> 3)) * LDP + C_MBK + h * 64 + (lane & 7) * 8;
    float a[8];
#pragma unroll
    for (int i = 0; i < 8; ++i) a[i] = 0.f;
#pragma unroll 8
    for (int i = 0; i < 32; ++i) { const u32x4 w = *(const u32x4*)(kb + (size_t)(8 * i) * LDP);
        a[0] += bflo(w.x); a[1] += bfhi(w.x); a[2] += bflo(w.y); a[3] += bfhi(w.y); a[4] += bflo(w.z); a[5] += bfhi(w.z); a[6] += bflo(w.w); a[7] += bfhi(w.w); }
#pragma unroll
    for (int i = 0; i < 8; ++i) { a[i] += __shfl_xor(a[i], 8); a[i] += __shfl_xor(a[i], 16); a[i] += __shfl_xor(a[i], 32); }
    if (lane < 8) { float* o = kmean + (size_t)item * 64 + lane * 8;
        *(f32x4*)o = (f32x4){a[0], a[1], a[2], a[3]} * (1.0f / 256.0f); *(f32x4*)(o + 4) = (f32x4){a[4], a[5], a[6], a[7]} * (1.0f / 256.0f); }
}
}

__device__ __forceinline__ void prep_kmean(const bf16_t* proj, float* kmean, LAS float* scr, int item, int tid) {
    const int n = item & 7, bh = item >> 3, b = bh >> 2, h = bh & 3, d = tid & 63, part = tid >> 6;
    const bf16_t* kb = proj + ((size_t)b * SEQ + n * 256 + part * 32) * LDP + C_MBK + h * 64 + d;
    float a = 0.f;
    for (int i = 0; i < 32; ++i) a += __uint_as_float((unsigned)kb[(size_t)i * LDP] << 16);
    scr[part * 64 + d] = a;
    __syncthreads();
    if (tid < 64) { float s = 0.f;
#pragma unroll
        for (int p = 0; p < 8; ++p) s += scr[p * 64 + tid];
        kmean[(size_t)item * 64 + tid] = s * (1.0f / 256.0f); }
    __syncthreads();
}
__device__ __forceinline__ void prep_compress_naive(const bf16_t* proj, const float* pos, const float* w1, const float* w2, bf16_t* outp, int col0, LAS float* scr, int b, int c, int tid) {
    LAS float* a = scr;
    LAS float* part = scr + 2048;
    LAS float* hid = scr + 2560;
    for (int i = tid; i < 2048; i += 512) { const int l = i >> 6, d = i & 63;
        a[i] = __uint_as_float((unsigned)proj[((size_t)b * SEQ + 16 * c + l) * LDP + col0 + d] << 16) + pos[i]; }
    __syncthreads();
    { const int j = tid & 255, kh = tid >> 8; float s = 0.f; const float* w = w1 + (size_t)kh * 1024 * 256 + j; const LAS float* ap = a + kh * 1024;
      for (int k = 0; k < 1024; ++k) s = fmaf(ap[k], w[(size_t)k * 256], s);
      part[kh * 256 + j] = s; }
    __syncthreads();
    if (tid < 256) hid[tid] = gelu_tanh(part[tid] + part[256 + tid]);
    __syncthreads();
    if (tid < 64) { float s = 0.f;
        for (int j = 0; j < 256; ++j) s = fmaf(hid[j], w2[j * 64 + tid], s);
        outp[((size_t)b * 128 + c) * 64 + tid] = (bf16_t)f2bf(s); }
    __syncthreads();
}

__global__ void __launch_bounds__(512, 2) hybrid_fwd(Args args) {
    extern __shared__ __attribute__((aligned(16))) unsigned char lds_raw[];
    cg::grid_group grid = cg::this_grid();
    LAS unsigned char* lds = (LAS unsigned char*)lds_raw;
    volatile LAS unsigned* xb_st = (volatile LAS unsigned*)(lds + LDS_BYTES - 16);
    if (threadIdx.x < 2) xb_st[threadIdx.x] = 0u;
    __syncthreads();
    if (threadIdx.x == 0) (void)xb_add(&((unsigned*)(opq(args.ws) + WS_BAR))[XB_XCNT(xb_xcc_id())], 1u);
#define XBAR() do { XcdBarrier xb_; xb_.bar = (unsigned*)(opq(args.ws) + WS_BAR); xb_.x = xb_xcc_id(); xb_.st = xb_st; xcd_barrier(xb_); } while (0)

    {
        const int tid = opq_tid(), lane = tid & 63, wave = __builtin_amdgcn_readfirstlane(tid >> 6), G = gridDim.x, bid = blockIdx.x, gw = bid * 8 + wave, NGW = G * 8;
        unsigned char* ws = opq(args.ws);
        float* rowss = (float*)(ws + WS_ROWSS); float* bt = (float*)(ws + WS_BIAS); bf16_t* xb = (bf16_t*)(ws + WS_XB);
        const float* x_in = args.in[0]; const float* rel_bias = args.in[15];
        for (int i = bid * 512 + tid; i < 4 * M_TOK; i += G * 512) rowss[M_TOK + i] = 0.f;
        for (int i = bid * 512 + tid; i < 12 * 128; i += G * 512) { const int col = i >> 7, d = i & 127; bt[i] = rel_bias[t5_bucket(d) * 12 + col]; }
        if (bid == 0 && wave < DEPTH) { const float* lv = args.in[13] + wave * 128; float a = 0.f, c2 = 0.f;
            if (lane < 32) { a = lv[lane] * lv[32 + lane]; c2 = lv[64 + lane] * lv[96 + lane]; }
            a = wave_sum(a); c2 = wave_sum(c2);
            if (lane == 0) ((float*)(ws + WS_LAM))[wave] = expf(a) - expf(c2) + (0.8f - 0.6f * expf(-0.3f * (float)wave)); }
        LAS float* scr = (LAS float*)lds + wave * (64 * 33);
        constexpr int T_IN = 16 * 93, T_OUT = 16 * 32, T_UP = 16 * 128, T_DOWN = 64 * 32, T_C1 = 32 * 8, T_C2 = 4 * 2, T_LAYER = T_IN + T_OUT + T_UP + T_DOWN + 2 * T_C1 + 2 * T_C2;
        for (int it = gw; it < DEPTH * T_LAYER; it += NGW) {
            const int layer = it / T_LAYER; int r = it % T_LAYER;
            if (r < T_IN) { transpose_item<true>(args.in[1] + (size_t)layer * DM * D_IN, args.in[5] + layer * DM, (bf16_t*)(ws + WS_WIN) + (size_t)layer * LDP * DM, DM, D_IN, r / 93, r % 93, scr, lane); continue; } r -= T_IN;
            if (r < T_OUT) { transpose_item<false>(args.in[2] + (size_t)layer * DM * DM, nullptr, (bf16_t*)(ws + WS_WOUT) + (size_t)layer * DM * DM, DM, DM, r / 32, r % 32, scr, lane); continue; } r -= T_OUT;
            if (r < T_UP) { transpose_item<false>(args.in[3] + (size_t)layer * DM * DFF, args.in[6] + layer * DM, (bf16_t*)(ws + WS_WUP) + (size_t)layer * DFF * DM, DM, DFF, r / 128, r % 128, scr, lane); continue; } r -= T_UP;
            if (r < T_DOWN) { transpose_item<false>(args.in[4] + (size_t)layer * DFF * DM, nullptr, (bf16_t*)(ws + WS_WDOWN) + (size_t)layer * DM * DFF, DFF, DM, r / 32, r % 32, scr, lane); continue; } r -= T_DOWN;
            if (r < 2 * T_C1) { const int kv = r / T_C1; r %= T_C1; transpose_item<false>(args.in[kv ? 11 : 9] + (size_t)layer * 2048 * 256, nullptr, (bf16_t*)(ws + WS_CW1) + (size_t)(layer * 2 + kv) * 256 * 2048, 2048, 256, r / 8, r % 8, scr, lane); continue; } r -= 2 * T_C1;
            { const int kv = r / T_C2; r %= T_C2; transpose_item<false>(args.in[kv ? 12 : 10] + (size_t)layer * 256 * 64, nullptr, (bf16_t*)(ws + WS_CW2) + (size_t)(layer * 2 + kv) * 64 * 256, 256, 64, r / 2, r % 2, scr, lane); }
        }
        for (int m = gw; m < M_TOK; m += NGW) {
            const f32x4* xr = (const f32x4*)(x_in + (size_t)m * DM) + lane; f32x4 v[4]; float s = 0.f;
#pragma unroll
            for (int j = 0; j < 4; ++j) { v[j] = xr[64 * j]; s += (v[j].x * v[j].x + v[j].y * v[j].y) + (v[j].z * v[j].z + v[j].w * v[j].w); }
            s = wave_sum(s); if (lane == 0) rowss[m] = s;
            unsigned long long* o8 = (unsigned long long*)(xb + (size_t)m * DM) + lane;
#pragma unroll
            for (int j = 0; j < 4; ++j) o8[64 * j] = (unsigned long long)pk2(v[j].x, v[j].y) | ((unsigned long long)pk2(v[j].z, v[j].w) << 32);
        }
    }
    if (args.ws == nullptr) grid.sync();
    XBAR();

    for (int layer = 0; layer < DEPTH; ++layer) {
#ifndef NO_P1
        { unsigned char* ws = opq(args.ws); const int G = gridDim.x, bid = blockIdx.x;
          pg8::Gemm g{(const bf16_t*)(ws + WS_XB), (const bf16_t*)(ws + WS_WIN) + (size_t)layer * LDP * DM, M_TOK, LDP, DM}; pg8::StaticOrder S; S.init(M_TOK, LDP, G, bid);
          pg8::EpiScale<0> E{(bf16_t*)(ws + WS_PROJ), LDP, (const float*)(ws + WS_ROWSS) + (size_t)(2 * layer) * M_TOK, 1.0f / DM};
          pg8::gemm_phase<pg8::EpiScale<0>, pg8::StaticOrder, true, true>(lds, g, S, E); }
#endif
        XBAR();
        { unsigned char* ws = opq(args.ws); const int tid = opq_tid(), G = gridDim.x, bid = blockIdx.x;
          const bf16_t* proj = (const bf16_t*)(ws + WS_PROJ); LAS float* scr = (LAS float*)lds;
          if (bid == 0) { ((bf16_t*)(ws + WS_KC))[((tid >> 6) * 128 + 127) * 64 + (tid & 63)] = 0; ((bf16_t*)(ws + WS_VC))[((tid >> 6) * 128 + 127) * 64 + (tid & 63)] = 0; }
          { const int lane = tid & 63, gw = bid * 8 + __builtin_amdgcn_readfirstlane(tid >> 6);
            for (int it = G * 8 - 1 - gw; it < 256; it += G * 8) at::kmean_item(proj, (float*)(ws + WS_KMEAN), it, lane); }
          for (int it = bid; it < 64; it += G) {
              const int kv = it >> 5, tile = it & 31;
              at::compress_unit(proj, kv ? C_NVC : C_NKC, args.in[kv ? 8 : 7] + layer * 2048, (const bf16_t*)(ws + WS_CW1) + (size_t)(layer * 2 + kv) * 256 * 2048,
                                (const bf16_t*)(ws + WS_CW2) + (size_t)(layer * 2 + kv) * 64 * 256, (bf16_t*)(ws + (kv ? WS_VC : WS_KC)), lds, tile);
          } }
        XBAR();
#ifndef NO_P3
        { unsigned char* ws = opq(args.ws); const int tid = opq_tid(), lane = tid & 63, wave = __builtin_amdgcn_readfirstlane(tid >> 6), G = gridDim.x, bid = blockIdx.x, gw = bid * 8 + wave, NGW = G * 8;
          const bf16_t* proj = (const bf16_t*)(ws + WS_PROJ); bf16_t* mixed = (bf16_t*)(ws + WS_MIXED); const float* bt = (const float*)(ws + WS_BIAS);
          const float lambda_init = 0.8f - 0.6f * expf(-0.3f * (float)layer);
          const float lam = ((const float*)(ws + WS_LAM))[layer];
#ifndef NO_NAIVE
          { const int tid_n = opq_tid(), lane_n = tid_n & 63; LAS float* imp = (LAS float*)lds + tid_n;
            for (int wi = gw; wi < 4096; wi += NGW) {
              const int mixer = wi & 3, r = wi >> 2, tb = 31 - (r & 31), bh = r >> 5, b = bh >> 2, h = bh & 3, t0 = tb * 64;
#ifdef NAIVE_SB
              if (mixer == 0) naive_sb(proj, mixed, b, h, t0, lane_n);
#endif
#ifdef NAIVE_MOBA
              if (mixer == 1) naive_moba(proj, (const float*)(ws + WS_KMEAN), bt, mixed, b, h, t0, lane_n);
#endif
#ifdef NAIVE_NSA
              if (mixer == 2) naive_nsa(proj, (const bf16_t*)(ws + WS_KC), (const bf16_t*)(ws + WS_VC), bt, (float*)(ws + WS_NSATMP), mixed, imp, b, h, t0, lane_n);
#endif
#ifdef NAIVE_DIFF
              if (mixer == 3) naive_diff(proj, bt, args.in[14] + layer * 64, lam, 1.0f - lambda_init, mixed, b, h, t0, lane_n);
#endif
            } }
#endif
          __syncthreads();
          for (int i = tid; i < 12 * at::BEXT; i += 512) { const int col = i / at::BEXT, d = i % at::BEXT - 64; const float bv = bt[col * 128 + imin(imax(d, 0), 127)] * at::LOG2E, bfar = bt[col * 128 + 127] * at::LOG2E;
              ((LAS float*)(lds + at::L_BIAS))[i] = bv; ((LAS float*)(lds + at::L_BIAS))[12 * at::BEXT + i] = (bv - bfar) / ((col < 8 ? 0.125f : 0.17677669529663687f) * at::LOG2E); }
          __syncthreads();
          { unsigned* qhead = (unsigned*)(ws + WS_QCTR) + layer * 64;
            volatile LAS int* slotp = (volatile LAS int*)(lds + LDS_BYTES - 32);
            for (;;) {
                if (tid == 0) *slotp = (int)atomicAdd(qhead, 1u);
                __syncthreads();
                const int s = *slotp;
                __syncthreads();
                if (s >= 1024) break;
                if (s < 768) { const int r = s / 96, w = s % 96, type = w >> 5, i = w & 31;
                    if (type == 0) at::diff_unit(proj, args.in[14] + layer * 64, lam, 1.0f - lambda_init, mixed, lds, i >> 2, i & 3, 7 - r);
                    else if (type == 1) at::nsa_unit(proj, (const bf16_t*)(ws + WS_KC), (const bf16_t*)(ws + WS_VC), mixed, lds, i & 7, 31 - 4 * r - (i >> 3));
                    else at::moba_unit(proj, (const float*)(ws + WS_KMEAN), mixed, lds, i >> 2, i & 3, 7 - r); }
                else { const int i = s - 768; at::sb_unit(proj, mixed, lds, (i & 31) >> 2, i & 3, 7 - (i >> 5)); }
            } }
          }
#endif
        XBAR();
#ifndef NO_P4
        { unsigned char* ws = opq(args.ws); const int G = gridDim.x, bid = blockIdx.x; float* xres = opq(args.out);
          pg8::Gemm g{(const bf16_t*)(ws + WS_MIXED), (const bf16_t*)(ws + WS_WOUT) + (size_t)layer * DM * DM, M_TOK, DM, DM}; pg8::StaticOrder S; S.init(M_TOK, DM, G, bid);
          pg8::EpiResidual E{layer == 0 ? args.in[0] : (const float*)xres, xres, (bf16_t*)(ws + WS_XB), (float*)(ws + WS_ROWSS) + (size_t)(2 * layer + 1) * M_TOK, DM};
          pg8::gemm_phase<pg8::EpiResidual, pg8::StaticOrder, true, true>(lds, g, S, E); }
#endif
        XBAR();
#ifndef NO_P5
        { unsigned char* ws = opq(args.ws); const int G = gridDim.x, bid = blockIdx.x;
          pg8::Gemm g{(const bf16_t*)(ws + WS_XB), (const bf16_t*)(ws + WS_WUP) + (size_t)layer * DFF * DM, M_TOK, DFF, DM}; pg8::StaticOrder S; S.init(M_TOK, DFF, G, bid);
          pg8::EpiScale<1> E{(bf16_t*)(ws + WS_PROJ), DFF, (const float*)(ws + WS_ROWSS) + (size_t)(2 * layer + 1) * M_TOK, 1.0f / DM};
          pg8::gemm_phase<pg8::EpiScale<1>, pg8::StaticOrder, true, true>(lds, g, S, E); }
#endif
        XBAR();
#ifndef NO_P6
        { unsigned char* ws = opq(args.ws); const int G = gridDim.x, bid = blockIdx.x; float* xres = opq(args.out);
          pg8::Gemm g{(const bf16_t*)(ws + WS_PROJ), (const bf16_t*)(ws + WS_WDOWN) + (size_t)layer * DM * DFF, M_TOK, DM, DFF}; pg8::StaticOrder S; S.init(M_TOK, DM, G, bid);
          pg8::EpiResidual E{xres, xres, (bf16_t*)(ws + WS_XB), (float*)(ws + WS_ROWSS) + (size_t)(2 * layer + 2) * M_TOK, DM};
          pg8::gemm_phase<pg8::EpiResidual, pg8::StaticOrder, true, true>(lds, g, S, E); }
#endif
        XBAR();
    }
    { const int tid = opq_tid(), lane = tid & 63, wave = __builtin_amdgcn_readfirstlane(tid >> 6), gw = blockIdx.x * 8 + wave, NGW = gridDim.x * 8;
      float* xres = opq(args.out); const float* final_norm = args.in[16];
      for (int m = gw; m < M_TOK; m += NGW) {
        f32x4* xr = (f32x4*)(xres + (size_t)m * DM) + lane; const f32x4* gr = (const f32x4*)final_norm + lane; f32x4 v[4]; float s = 0.f;
#pragma unroll
        for (int j = 0; j < 4; ++j) { v[j] = xr[64 * j]; s += (v[j].x * v[j].x + v[j].y * v[j].y) + (v[j].z * v[j].z + v[j].w * v[j].w); }
        const float rs = 1.0f / sqrtf(wave_sum(s) * (1.0f / DM) + 1e-6f);
#pragma unroll
        for (int j = 0; j < 4; ++j) xr[64 * j] = v[j] * rs * gr[64 * j];
      } }
}

extern "C" void kernel_launch(void* const* d_in, const int* in_sizes, int n_in, void* d_out, int out_size, void* d_ws, size_t ws_size, hipStream_t stream) {
    static int grid = 0;
    if (grid == 0) {
        int dev = 0, cus = 0, per_cu = 0;
        if (n_in != 17 || out_size != M_TOK * DM || ws_size < WS_END) { fprintf(stderr, "kernel_launch: unexpected shapes (n_in %d out %d ws %zu)\n", n_in, out_size, ws_size); grid = -1; return; }
        (void)hipGetDevice(&dev); (void)hipDeviceGetAttribute(&cus, hipDeviceAttributeMultiprocessorCount, dev);
        if (hipFuncSetAttribute((const void*)hybrid_fwd, hipFuncAttributeMaxDynamicSharedMemorySize, LDS_BYTES) != hipSuccess) { fprintf(stderr, "kernel_launch: hipFuncSetAttribute failed\n"); grid = -1; return; }
        if (hipOccupancyMaxActiveBlocksPerMultiprocessor(&per_cu, (const void*)hybrid_fwd, 512, LDS_BYTES) != hipSuccess || per_cu < 1) { fprintf(stderr, "kernel_launch: occupancy query gave %d\n", per_cu); grid = -1; return; }
        grid = cus * per_cu;
    }
    if (grid < 0) return;
    if (hipMemsetAsync((char*)d_ws + WS_BAR, 0, 16384, stream) != hipSuccess) { fprintf(stderr, "kernel_launch: hipMemsetAsync failed\n"); return; }
    Args a{};
    for (int i = 0; i < 17; ++i) a.in[i] = (const float*)d_in[i];
    a.out = (float*)d_out; a.ws = (unsigned char*)d_ws;
    void* kargs[] = {&a};
    hipError_t e = hipLaunchCooperativeKernel((const void*)hybrid_fwd, dim3(grid), dim3(512), kargs, LDS_BYTES, stream);
    if (e != hipSuccess) fprintf(stderr, "cooperative launch failed: %s (grid %d)\n", hipGetErrorString(e), grid);
}
```

```cpp
#include <hip/hip_runtime.h>
#include <hip/hip_cooperative_groups.h>
#include <cstdio>
#include <cstdint>
namespace cg = cooperative_groups;

namespace pg8 {
#define PG8_LAS __attribute__((address_space(3)))
typedef unsigned short bf16_t;
typedef short bf16x8 __attribute__((ext_vector_type(8)));
typedef float f32x4 __attribute__((ext_vector_type(4)));
typedef unsigned u32x4 __attribute__((ext_vector_type(4)));
constexpr int BM = 256, BK = 64, HALF = 128, HTB = HALF * BK * 2  , STAGE_BYTES = 8 * HTB, NXCD = 8, WGM = 8;

__host__ __device__ __forceinline__ int lds_byte(int r, int c) { const int st = (r >> 4) * 2 + (c >> 5), rr = r & 15, cc = c & 31, ob = rr * 64 + cc * 2; return st * 1024 + (ob ^ (((ob >> 9) & 1) << 5)); }
__host__ __device__ __forceinline__ void stage_rc(int b, int& R, int& C) { const int st = b / 1024, sb = b % 1024, swz = sb ^ (((sb >> 9) & 1) << 5); R = (st >> 1) * 16 + swz / 64; C = (st & 1) * 32 + (swz % 64) / 2; }
__host__ __device__ __forceinline__ int perm32(int rho) { const int n = rho >> 4, i = rho & 15; return 8 * (i >> 2) + 4 * n + (i & 3); }

struct Unit { int pm, pn; };
struct Gemm { const bf16_t* A; const bf16_t* Bt; int M, N, K; };

struct StaticOrder {
    int nM, nN, nwg, G, c;
    __host__ __device__ void init(int M, int N, int G_, int c_) { nM = M / BM; nN = N / BM; nwg = nM * nN; G = G_; c = c_; }
    __host__ __device__ bool next(int i, Unit& u) const {
        const long L = (long)i * G + c; if (L >= nwg) return false;
        int wgid = (int)L; { const int q = nwg / NXCD, r = nwg % NXCD, xcd = wgid % NXCD, off = wgid / NXCD; wgid = (xcd < r ? xcd * (q + 1) : r * (q + 1) + (xcd - r) * q) + off; }
        const int nig = WGM * nN, gid = wgid / nig, fm = gid * WGM, gsz = (nM - fm) < WGM ? (nM - fm) : WGM;
        u.pm = fm + ((wgid % nig) % gsz); u.pn = (wgid % nig) / gsz; return true;
    }
    __device__ __forceinline__ void a_ready(const Unit&) const {}
    __device__ __forceinline__ void done(const Unit&) const {}
};


__device__ __forceinline__ unsigned cvt_pk_bf16(float lo, float hi) { unsigned r; asm volatile("v_cvt_pk_bf16_f32 %0, %1, %2" : "=v"(r) : "v"(lo), "v"(hi)); return r; }
constexpr float NORM_EPS = 1e-6f;
template <int ACT> struct EpiScale {
    static constexpr bool PERM = true, AFTER_DRAIN = false;
    bf16_t* O; int ldc; const float* rowss; float inv_d;
    __device__ __forceinline__ void operator()(const f32x4 (&acc)[2][2][4][2], const Unit& u, int wr, int wc, int fr, int fq) const {
        const int row0 = u.pm * BM + wr * 64 + fr, col0 = u.pn * BM + wc * 32 + 8 * fq;
#pragma unroll
        for (int ai = 0; ai < 2; ++ai)
#pragma unroll
            for (int m = 0; m < 4; ++m) { const int row = row0 + ai * HALF + m * 16; const float rs = 1.0f / sqrtf(rowss[row] * inv_d + NORM_EPS);
                bf16_t* rowp = O + (size_t)row * ldc + col0;
#pragma unroll
                for (int bj = 0; bj < 2; ++bj) { f32x4 v0 = acc[ai][bj][m][0] * rs, v1 = acc[ai][bj][m][1] * rs;
                    if (ACT == 1) {
#pragma unroll
                        for (int e = 0; e < 4; ++e) { const float a = fmaxf(v0[e], 0.f), b = fmaxf(v1[e], 0.f); v0[e] = a * a; v1[e] = b * b; } }
                    u32x4 w; w.x = cvt_pk_bf16(v0[0], v0[1]); w.y = cvt_pk_bf16(v0[2], v0[3]); w.z = cvt_pk_bf16(v1[0], v1[1]); w.w = cvt_pk_bf16(v1[2], v1[3]);
                    *(u32x4*)(rowp + bj * HALF) = w; } }
    }
};
struct EpiResidual {
    static constexpr bool PERM = true, AFTER_DRAIN = false;
    const float* xin; float* xout; bf16_t* xb; float* rowss_out; int ldc;
    __device__ __forceinline__ void operator()(const f32x4 (&acc)[2][2][4][2], const Unit& u, int wr, int wc, int fr, int fq) const {
        const int row0 = u.pm * BM + wr * 64 + fr, col0 = u.pn * BM + wc * 32 + 8 * fq;
#pragma unroll
        for (int ai = 0; ai < 2; ++ai)
#pragma unroll
            for (int m = 0; m < 4; ++m) { const int row = row0 + ai * HALF + m * 16; const size_t off = (size_t)row * ldc + col0; float ss = 0.f;
#pragma unroll
                for (int bj = 0; bj < 2; ++bj) { const f32x4 r0 = *(const f32x4*)(xin + off + bj * HALF), r1 = *(const f32x4*)(xin + off + bj * HALF + 4);
                    const f32x4 v0 = r0 + acc[ai][bj][m][0], v1 = r1 + acc[ai][bj][m][1];
                    *(f32x4*)(xout + off + bj * HALF) = v0; *(f32x4*)(xout + off + bj * HALF + 4) = v1;
                    u32x4 w; w.x = cvt_pk_bf16(v0[0], v0[1]); w.y = cvt_pk_bf16(v0[2], v0[3]); w.z = cvt_pk_bf16(v1[0], v1[1]); w.w = cvt_pk_bf16(v1[2], v1[3]);
                    *(u32x4*)(xb + off + bj * HALF) = w;
                    ss += (v0[0] * v0[0] + v0[1] * v0[1]) + (v0[2] * v0[2] + v0[3] * v0[3]) + (v1[0] * v1[0] + v1[1] * v1[1]) + (v1[2] * v1[2] + v1[3] * v1[3]); }
                ss += __shfl_xor(ss, 16); ss += __shfl_xor(ss, 32);
                if (fq == 0) atomicAdd(rowss_out + row, ss); }
    }
};

template <class Epi, class Sched, bool ALIGN_EPI = false, bool SP2 = false>
__device__ __forceinline__ void gemm_phase(PG8_LAS unsigned char* lds, const Gemm g, const Sched& S, const Epi& E) {
    int tid_o = threadIdx.x; asm volatile("" : "+v"(tid_o));
    const int tid = tid_o, wid = __builtin_amdgcn_readfirstlane(tid >> 6), lane = tid & 63, wr = wid >> 2, wc = wid & 3, fr = lane & 15, fq = lane >> 4;
    const int K = g.K, nt = K / BK;
    unsigned voffA[2], voffB[2];
#pragma unroll
    for (int i = 0; i < 2; ++i) { int R, C; stage_rc(tid * 16 + i * 8192, R, C); const int Rb = Epi::PERM ? ((R & ~31) + perm32(R & 31)) : R;
        voffA[i] = (unsigned)(R * K + C) * 2u; voffB[i] = (unsigned)(Rb * K + C) * 2u; }
    const size_t kstep = (size_t)(BK * 2);
    const size_t hstep = (size_t)HALF * K * 2;
    const size_t tstep = 2 * hstep;
    const unsigned ldsw = (unsigned)wid * 1024u;
    const int aoff = lds_byte(wr * 64 + fr, fq * 8), boff = lds_byte(wc * 32 + fr, fq * 8);
#define PG8_SA(b, h) (((b) * 2 + (h)) * HTB)
#define PG8_SB(b, h) ((4 + (b) * 2 + (h)) * HTB)
#define PG8_STAGE(bufoff, gbase, voff) do { _Pragma("unroll") for (int _i = 0; _i < 2; ++_i) \
        __builtin_amdgcn_global_load_lds((const unsigned*)((const char*)(gbase) + (voff)[_i]), (PG8_LAS unsigned*)(lds + (bufoff) + ldsw + _i * 8192), 16, 0, 0); } while (0)
#define PG8_LDA(dst, b, h) do { _Pragma("unroll") for (int m = 0; m < 4; ++m) _Pragma("unroll") for (int k = 0; k < 2; ++k) dst[m][k] = *(const PG8_LAS bf16x8*)(lds + PG8_SA(b, h) + aoff + m * 2048 + k * 1024); } while (0)
#define PG8_LDB(dst, b, h) do { _Pragma("unroll") for (int n = 0; n < 2; ++n) _Pragma("unroll") for (int k = 0; k < 2; ++k) dst[n][k] = *(const PG8_LAS bf16x8*)(lds + PG8_SB(b, h) + boff + n * 2048 + k * 1024); } while (0)
#define PG8_MMA(ai, bj, At, Bt) do { __builtin_amdgcn_s_setprio(1); _Pragma("unroll") for (int m = 0; m < 4; ++m) _Pragma("unroll") for (int n = 0; n < 2; ++n) _Pragma("unroll") for (int k = 0; k < 2; ++k) \
        acc[ai][bj][m][n] = __builtin_amdgcn_mfma_f32_16x16x32_bf16(Bt[n][k], At[m][k], acc[ai][bj][m][n], 0, 0, 0); __builtin_amdgcn_s_setprio(0); } while (0)
#define PG8_WAIT_V(n) asm volatile("s_waitcnt vmcnt(" #n ")" ::: "memory")
#define PG8_WAIT_L(n) asm volatile("s_waitcnt lgkmcnt(" #n ")" ::: "memory")
#define PG8_BAR __builtin_amdgcn_s_barrier()
#define PG8_SCHED __builtin_amdgcn_sched_barrier(0)
    Unit cur, nxt; int ui = 0;
    if (!S.next(0, cur)) return;
    f32x4 acc[2][2][4][2];
#pragma unroll
    for (int a = 0; a < 2; ++a)
#pragma unroll
        for (int b = 0; b < 2; ++b)
#pragma unroll
            for (int m = 0; m < 4; ++m)
#pragma unroll
                for (int n = 0; n < 2; ++n) acc[a][b][m][n] = (f32x4){0.f, 0.f, 0.f, 0.f};
    bf16x8 At[4][2], B0[2][2], B1[2][2];
    const char* cA = (const char*)g.A + (size_t)cur.pm * tstep; const char* cB = (const char*)g.Bt + (size_t)cur.pn * tstep;
    S.a_ready(cur);
    if constexpr (SP2) {
        PG8_STAGE(PG8_SB(0, 0), cB, voffB); PG8_STAGE(PG8_SB(0, 1), cB + hstep, voffB); PG8_STAGE(PG8_SA(0, 0), cA, voffA); PG8_STAGE(PG8_SA(0, 1), cA + hstep, voffA);
        if (wr == 1) PG8_BAR;
        PG8_WAIT_V(2); PG8_BAR;
        PG8_STAGE(PG8_SB(1, 0), cB + kstep, voffB); PG8_STAGE(PG8_SA(1, 0), cA + kstep, voffA); PG8_STAGE(PG8_SB(1, 1), cB + hstep + kstep, voffB);
        PG8_WAIT_V(6); PG8_BAR;
    } else {
        PG8_STAGE(PG8_SB(0, 0), cB, voffB); PG8_STAGE(PG8_SA(0, 0), cA, voffA); PG8_STAGE(PG8_SB(0, 1), cB + hstep, voffB); PG8_STAGE(PG8_SA(0, 1), cA + hstep, voffA);
        if (wr == 1) PG8_BAR;
        PG8_WAIT_V(4); PG8_BAR;
        PG8_STAGE(PG8_SB(1, 0), cB + kstep, voffB); PG8_STAGE(PG8_SA(1, 0), cA + kstep, voffA); PG8_STAGE(PG8_SB(1, 1), cB + hstep + kstep, voffB);
        PG8_WAIT_V(6); PG8_BAR;
    }
    for (;;) {
        const bool has_next = S.next(ui + 1, nxt);
        const char* nA = has_next ? (const char*)g.A + (size_t)nxt.pm * tstep : cA; const char* nB = has_next ? (const char*)g.Bt + (size_t)nxt.pn * tstep : cB;
        for (int t = 0; t < nt; t += 2) {
            const bool last = (t == nt - 2);
            const char* a1 = cA + (size_t)(t + 1) * kstep;
            const char* a2 = last ? nA : cA + (size_t)(t + 2) * kstep; const char* b2 = last ? nB : cB + (size_t)(t + 2) * kstep;
            const char* a3 = a2 + kstep; const char* b3 = b2 + kstep;
            if (last && has_next) S.a_ready(nxt);
            if constexpr (SP2) {
            PG8_LDB(B0, 0, 0); PG8_LDB(B1, 0, 1); PG8_SCHED; PG8_LDA(At, 0, 0); PG8_STAGE(PG8_SA(1, 1), a1 + hstep, voffA);
            PG8_WAIT_V(8); PG8_WAIT_L(0); PG8_BAR; PG8_MMA(0, 0, At, B0); PG8_MMA(0, 1, At, B1); PG8_BAR; PG8_SCHED;
            PG8_LDA(At, 0, 1); PG8_STAGE(PG8_SB(0, 0), b2, voffB); PG8_STAGE(PG8_SB(0, 1), b2 + hstep, voffB); PG8_STAGE(PG8_SA(0, 0), a2, voffA);
            PG8_WAIT_V(8); PG8_WAIT_L(0); PG8_BAR; PG8_MMA(1, 0, At, B0); PG8_MMA(1, 1, At, B1); PG8_BAR; PG8_SCHED;
            PG8_LDB(B0, 1, 0); PG8_LDB(B1, 1, 1); PG8_SCHED; PG8_LDA(At, 1, 0); PG8_STAGE(PG8_SA(0, 1), a2 + hstep, voffA);
            PG8_WAIT_V(8); PG8_WAIT_L(0); PG8_BAR; PG8_MMA(0, 0, At, B0); PG8_MMA(0, 1, At, B1); PG8_BAR; PG8_SCHED;
            PG8_LDA(At, 1, 1); PG8_STAGE(PG8_SB(1, 0), b3, voffB); PG8_STAGE(PG8_SB(1, 1), b3 + hstep, voffB); PG8_STAGE(PG8_SA(1, 0), a3, voffA);
            PG8_WAIT_V(8); PG8_WAIT_L(0); PG8_BAR; PG8_MMA(1, 0, At, B0); PG8_MMA(1, 1, At, B1); PG8_BAR; PG8_SCHED;
            } else {
            PG8_LDB(B0, 0, 0); PG8_SCHED; PG8_LDA(At, 0, 0); PG8_STAGE(PG8_SA(1, 1), a1 + hstep, voffA);
            PG8_WAIT_L(8); PG8_BAR; PG8_WAIT_L(0); PG8_MMA(0, 0, At, B0); PG8_BAR; PG8_SCHED;
            PG8_LDB(B1, 0, 1); PG8_STAGE(PG8_SB(0, 0), b2, voffB);
            PG8_BAR; PG8_WAIT_L(0); PG8_MMA(0, 1, At, B1); PG8_BAR;
            PG8_LDA(At, 0, 1); PG8_STAGE(PG8_SA(0, 0), a2, voffA);
            PG8_BAR; PG8_WAIT_L(0); PG8_MMA(1, 0, At, B0); PG8_BAR; PG8_SCHED;
            PG8_STAGE(PG8_SB(0, 1), b2 + hstep, voffB);
            PG8_WAIT_V(6); PG8_BAR; PG8_MMA(1, 1, At, B1); PG8_BAR;
            PG8_LDB(B0, 1, 0); PG8_SCHED; PG8_LDA(At, 1, 0); PG8_STAGE(PG8_SA(0, 1), a2 + hstep, voffA);
            PG8_WAIT_L(8); PG8_BAR; PG8_WAIT_L(0); PG8_MMA(0, 0, At, B0); PG8_BAR; PG8_SCHED;
            PG8_LDB(B1, 1, 1); PG8_STAGE(PG8_SB(1, 0), b3, voffB);
            PG8_BAR; PG8_WAIT_L(0); PG8_MMA(0, 1, At, B1); PG8_BAR;
            PG8_LDA(At, 1, 1); PG8_STAGE(PG8_SA(1, 0), a3, voffA);
            PG8_BAR; PG8_WAIT_L(0); PG8_MMA(1, 0, At, B0); PG8_BAR; PG8_SCHED;
            PG8_STAGE(PG8_SB(1, 1), b3 + hstep, voffB);
            PG8_WAIT_V(6); PG8_BAR; PG8_MMA(1, 1, At, B1); PG8_BAR;
            }
        }
        if constexpr (ALIGN_EPI) { if (wr == 0) PG8_BAR; }
        if constexpr (!Epi::AFTER_DRAIN) { E(acc, cur, wr, wc, fr, fq); S.done(cur); }
        if (!has_next) break;
#pragma unroll
        for (int a = 0; a < 2; ++a)
#pragma unroll
            for (int b = 0; b < 2; ++b)
#pragma unroll
                for (int m = 0; m < 4; ++m)
#pragma unroll
                    for (int n = 0; n < 2; ++n) acc[a][b][m][n] = (f32x4){0.f, 0.f, 0.f, 0.f};
        cur = nxt; cA = nA; cB = nB; ++ui;
        if constexpr (ALIGN_EPI) { if (wr == 1) PG8_BAR; }
    }
    PG8_WAIT_V(0);
    if constexpr (!ALIGN_EPI) { if (wr == 0) PG8_BAR; }
    PG8_BAR;
    if constexpr (Epi::AFTER_DRAIN) { E.fused(acc, cur, wr, wc, fr, fq, lds, wid, lane); S.done(cur); }
#undef PG8_SA
#undef PG8_SB
#undef PG8_STAGE
#undef PG8_LDA
#undef PG8_LDB
#undef PG8_MMA
#undef PG8_WAIT_V
#undef PG8_WAIT_L
#undef PG8_BAR
#undef PG8_SCHED
}
}

#define LAS __attribute__((address_space(3)))
typedef unsigned short bf16_t;
typedef unsigned u32x4 __attribute__((ext_vector_type(4)));
typedef float f32x4 __attribute__((ext_vector_type(4)));
constexpr int BATCH = 8, SEQ = 2048, DM = 1024, DEPTH = 2, HD = 64, DFF = 4096, M_TOK = BATCH * SEQ;
constexpr int D_IN = 2956, LDP = 3072;
constexpr int C_SBQ = 0, C_SBK = 256, C_SBV = 512, C_MBQ = 768, C_MBK = 1024, C_MBV = 1280, C_NSQ = 1536, C_NKC = 1792, C_NVC = 1856, C_NKS = 1920, C_NVS = 1984,
              C_NKW = 2048, C_NVW = 2112, C_DFQ = 2176, C_DFK = 2432, C_DFV = 2688, C_NSG = 2944;
constexpr int N_CMP = 127;
constexpr float NEG_BIG = -1e30f, TINY = 1e-30f;
constexpr size_t MiB = 1u << 20;
constexpr size_t WS_ROWSS = 1 * MiB;
constexpr size_t WS_BIAS = 1 * MiB + 512 * 1024;
constexpr size_t WS_ORDER = WS_BIAS + 48 * 1024;
constexpr size_t WS_QCTR = 14336;
constexpr size_t WS_LAM = WS_BIAS + 32 * 1024;
constexpr size_t WS_KMEAN = WS_BIAS + 64 * 1024;
constexpr size_t WS_KC = 2 * MiB, WS_VC = 2 * MiB + 128 * 1024;
constexpr size_t WS_CW1 = 3 * MiB, WS_CW2 = 7 * MiB;
constexpr size_t WS_WIN = 8 * MiB, WS_WOUT = 20 * MiB, WS_WUP = 24 * MiB, WS_WDOWN = 40 * MiB;
constexpr size_t WS_PROJ = 56 * MiB;
constexpr size_t WS_NSATMP = WS_PROJ + 96 * MiB;
constexpr size_t WS_MIXED = 184 * MiB, WS_XB = 216 * MiB, WS_END = 248 * MiB;
constexpr int LDS_BYTES = 147456;

struct Args { const float* in[17]; float* out; unsigned char* ws; };

__device__ __forceinline__ float bflo(unsigned u) { return __uint_as_float(u << 16); }
__device__ __forceinline__ float bfhi(unsigned u) { return __uint_as_float(u & 0xffff0000u); }
__device__ __forceinline__ unsigned f2bf(float f) { unsigned u = __float_as_uint(f); return (u + 0x7fffu + ((u >> 16) & 1u)) >> 16; }
__device__ __forceinline__ unsigned pk2(float lo, float hi) { return f2bf(lo) | (f2bf(hi) << 16); }
__device__ __forceinline__ float wave_sum(float v) {
#pragma unroll
    for (int o = 1; o < 64; o <<= 1) v += __shfl_xor(v, o);
    return v;
}
__device__ __forceinline__ int t5_bucket(int n) {
    if (n < 16) return n;
    const int large = 16 + (int)(logf((float)n * (1.0f / 16.0f)) / 2.0794415416798357f * 16.0f);
    return large < 31 ? large : 31;
}

constexpr size_t WS_BAR = 0;
#define XB_TMO      128
#define XB_XCNT(j)  (256  + 64 * (j))
#define XB_XSUB(j)  (1280 + 64 * (j))
#define XB_XGEN(j)  (2304 + 64 * (j))
#define XB_TOP      3328
#define XB_TOPGEN   3392
#define XCD_BAR_WORDS 3456
#define XB_SPIN_CAP (1u << 18)

__device__ __forceinline__ unsigned xb_ld(unsigned* p)              { return __hip_atomic_load(p, __ATOMIC_RELAXED, __HIP_MEMORY_SCOPE_AGENT); }
__device__ __forceinline__ unsigned xb_add(unsigned* p, unsigned v) { return __hip_atomic_fetch_add(p, v, __ATOMIC_RELAXED, __HIP_MEMORY_SCOPE_AGENT); }
__device__ __forceinline__ unsigned xb_xcc_id() { return (unsigned)__builtin_amdgcn_s_getreg((3 << 11) | 20) & 0xFu; }
#define XB_SPIN(cond, bar) do { unsigned _sp = 0; while (cond) { __builtin_amdgcn_s_sleep(1); \
    if ((++_sp & 255u) == 0u) { if (xb_ld(&(bar)[XB_TMO])) break; if (_sp > XB_SPIN_CAP) { atomicAdd(&(bar)[XB_TMO], 1u); break; } } } } while (0)

struct XcdBarrier {
    unsigned* bar; unsigned x;
    volatile LAS unsigned* st;
};

__device__ __forceinline__ XcdBarrier xcd_barrier_post(unsigned* bar, volatile LAS unsigned* st) {
    XcdBarrier b; b.bar = bar; b.x = xb_xcc_id(); b.st = st;
    if (threadIdx.x == 0) (void)xb_add(&bar[XB_XCNT(b.x)], 1u);
    return b;
}
__device__ __forceinline__ void xcd_barrier_complete(unsigned* bar, unsigned x, unsigned& nloc, unsigned& nx) {
    const unsigned G = gridDim.x * gridDim.y * gridDim.z;
    unsigned sum, cnt, mine, sp = 0u;
    for (;;) {
        sum = 0u; cnt = 0u; mine = 0u;
#pragma unroll
        for (unsigned j = 0; j < 16; ++j) { const unsigned c = xb_ld(&bar[XB_XCNT(j)]); sum += c; cnt += (c > 0u) ? 1u : 0u; mine = (j == x) ? c : mine; }
        if (sum == G) break;
        __builtin_amdgcn_s_sleep(1);
        if ((++sp & 255u) == 0u) { if (xb_ld(&bar[XB_TMO])) break; if (sp > XB_SPIN_CAP) { atomicAdd(&bar[XB_TMO], 1u); break; } }
    }
    nloc = mine > 0u ? mine : 1u; nx = cnt > 0u ? cnt : 1u;
}

__device__ __forceinline__ void xcd_barrier(const XcdBarrier& b) {
    asm volatile("s_waitcnt vmcnt(0)" ::: "memory");
    __syncthreads();
    if (threadIdx.x == 0) {
        unsigned* bar = b.bar;
        __builtin_amdgcn_s_waitcnt(0);
        unsigned nloc = b.st[0], nx = b.st[1];
        if (nloc == 0u) { xcd_barrier_complete(bar, b.x, nloc, nx); b.st[0] = nloc; b.st[1] = nx; }
        const unsigned old = xb_add(&bar[XB_XSUB(b.x)], 1u);
        const unsigned gen = old / nloc;
        if (old + 1u == (gen + 1u) * nloc) {
            __builtin_amdgcn_fence(__ATOMIC_RELEASE, "agent");
            asm volatile("s_waitcnt vmcnt(0)" ::: "memory");
            const unsigned og = xb_add(&bar[XB_TOP], 1u);
            const unsigned tg = og / nx;
            if (og + 1u == (tg + 1u) * nx) xb_add(&bar[XB_TOPGEN], 1u);
            else XB_SPIN(xb_ld(&bar[XB_TOPGEN]) == tg, bar);
            __builtin_amdgcn_fence(__ATOMIC_ACQUIRE, "agent");
            xb_add(&bar[XB_XGEN(b.x)], 1u);
            asm volatile("s_waitcnt vmcnt(0)" ::: "memory");
        } else {
            XB_SPIN(xb_ld(&bar[XB_XGEN(b.x)]) == gen, bar);
            __builtin_amdgcn_fence(__ATOMIC_ACQUIRE, "agent");
            asm volatile("s_waitcnt vmcnt(0)" ::: "memory");
        }
    }
    __syncthreads();
}

__device__ __forceinline__ float unit_cost(int id) { const int type = id >> 8, idx = id & 255;
    if (type == 0) return 5.6f * (float)((idx >> 5) + 1) + 1.0f;
    if (type == 1) { const int own = idx >> 3; return 5.0f + (float)(own + 1) + (float)(own + 1 < 9 ? own + 1 : 9); }
    if (type == 2) return 4.0f * (float)((idx >> 5) + 1) + 1.5f;
    return 9.0f; }
__device__ __forceinline__ int win_dest(int n) { return n < 2176 ? n : (n < 2188 ? 2944 + (n - 2176) : n - 12); }
template <bool MAP> __device__ __forceinline__ void transpose_item(const float* W, const float* g, bf16_t* WT, int K, int N, int kb, int nb, LAS float* scr, int lane) {
    const int k0 = kb * 64, n0 = nb * 32, nn = lane & 31; const bool inb = n0 + nn < N;
#pragma unroll 8
    for (int i = 0; i < 32; ++i) { const int kk = 2 * i + (lane >> 5); float v = inb ? W[(size_t)(k0 + kk) * N + n0 + nn] : 0.f; if (g) v *= g[k0 + kk]; scr[kk * 33 + nn] = v; }
    asm volatile("s_waitcnt lgkmcnt(0)" ::: "memory");
    const int c = lane & 7;
#pragma unroll
    for (int j = 0; j < 4; ++j) { const int n = (lane >> 3) + 8 * j; const LAS float* s = scr + (8 * c) * 33 + n;
        u32x4 o; o.x = pk2(s[0], s[33]); o.y = pk2(s[2 * 33], s[3 * 33]); o.z = pk2(s[4 * 33], s[5 * 33]); o.w = pk2(s[6 * 33], s[7 * 33]);
        if (n0 + n < N) { const int dest = MAP ? win_dest(n0 + n) : (n0 + n); *(u32x4*)(WT + (size_t)dest * K + k0 + 8 * c) = o; } }
    asm volatile("s_waitcnt lgkmcnt(0)" ::: "memory");
}

template <int NC> __device__ __forceinline__ float dotq(const float* q, const bf16_t* row) {
    const uint4* p = (const uint4*)row; float a = 0.f;
#pragma unroll
    for (int c = 0; c < NC; ++c) { const uint4 w = p[c];
        a = fmaf(q[8 * c + 0], bflo(w.x), a); a = fmaf(q[8 * c + 1], bfhi(w.x), a); a = fmaf(q[8 * c + 2], bflo(w.y), a); a = fmaf(q[8 * c + 3], bfhi(w.y), a);
        a = fmaf(q[8 * c + 4], bflo(w.z), a); a = fmaf(q[8 * c + 5], bfhi(w.z), a); a = fmaf(q[8 * c + 6], bflo(w.w), a); a = fmaf(q[8 * c + 7], bfhi(w.w), a); }
    return a;
}
__device__ __forceinline__ void axpy64(float* o, float p, const bf16_t* row) {
    const uint4* v = (const uint4*)row;
#pragma unroll
    for (int c = 0; c < 8; ++c) { const uint4 w = v[c];
        o[8 * c + 0] = fmaf(p, bflo(w.x), o[8 * c + 0]); o[8 * c + 1] = fmaf(p, bfhi(w.x), o[8 * c + 1]); o[8 * c + 2] = fmaf(p, bflo(w.y), o[8 * c + 2]); o[8 * c + 3] = fmaf(p, bfhi(w.y), o[8 * c + 3]);
        o[8 * c + 4] = fmaf(p, bflo(w.z), o[8 * c + 4]); o[8 * c + 5] = fmaf(p, bfhi(w.z), o[8 * c + 5]); o[8 * c + 6] = fmaf(p, bflo(w.w), o[8 * c + 6]); o[8 * c + 7] = fmaf(p, bfhi(w.w), o[8 * c + 7]); }
}
__device__ __forceinline__ void loadq64(float* q, const bf16_t* row) {
    const uint4* p = (const uint4*)row;
#pragma unroll
    for (int c = 0; c < 8; ++c) { const uint4 w = p[c]; q[8 * c + 0] = bflo(w.x); q[8 * c + 1] = bfhi(w.x); q[8 * c + 2] = bflo(w.y); q[8 * c + 3] = bfhi(w.y);
        q[8 * c + 4] = bflo(w.z); q[8 * c + 5] = bfhi(w.z); q[8 * c + 6] = bflo(w.w); q[8 * c + 7] = bfhi(w.w); }
}
__device__ __forceinline__ void store64_bf16(bf16_t* dst, const float* o, float sc) {
#pragma unroll
    for (int c = 0; c < 8; ++c) { u32x4 w; w.x = pk2(o[8 * c] * sc, o[8 * c + 1] * sc); w.y = pk2(o[8 * c + 2] * sc, o[8 * c + 3] * sc); w.z = pk2(o[8 * c + 4] * sc, o[8 * c + 5] * sc); w.w = pk2(o[8 * c + 6] * sc, o[8 * c + 7] * sc);
        *(u32x4*)(dst + 8 * c) = w; }
}
__device__ __forceinline__ int opq_tid() { int t = threadIdx.x; asm volatile("" : "+v"(t)); return t; }
template <class T> __device__ __forceinline__ T* opq(T* p) { asm volatile("" : "+s"(p)); return p; }
__device__ __forceinline__ float gelu_tanh(float x) { const float u = 0.7978845608028654f * (x + 0.044715f * x * x * x); return 0.5f * x * (1.0f + tanhf(u)); }
__device__ __forceinline__ int imin(int a, int b) { return a < b ? a : b; }
__device__ __forceinline__ int imax(int a, int b) { return a > b ? a : b; }

__device__ __forceinline__ void naive_sb(const bf16_t* proj, bf16_t* mixed, int b, int h, int t0, int lane) {
    const int t = t0 + lane; const size_t row = (size_t)b * SEQ + t;
    float q[64], o[64];
    loadq64(q, proj + row * LDP + C_SBQ + h * 64);
#pragma unroll
    for (int i = 0; i < 64; ++i) o[i] = 0.f;
    float R = 0.f;
    const bf16_t* kb = proj + (size_t)b * SEQ * LDP + C_SBK + h * 64; const bf16_t* vb = proj + (size_t)b * SEQ * LDP + C_SBV + h * 64;
    for (int s = t0 + 62; s >= 0; --s) {
        const bool act = s < t;
        const float z = dotq<8>(q, kb + (size_t)s * LDP) * 0.125f;
        const float sp = fmaxf(z, 0.f) + log1pf(expf(-fabsf(z)));
        const float a = act ? expf((z - sp) + R) : 0.f;
        if (act) R -= sp;
        axpy64(o, a, vb + (size_t)s * LDP);
        if (__all(R < -104.f)) break;
    }
    store64_bf16(mixed + row * DM + 0 + h * 64, o, 1.f);
}

__device__ __forceinline__ void naive_moba(const bf16_t* proj, const float* kmean, const float* bt, bf16_t* mixed, int b, int h, int t0, int lane) {
    const int t = t0 + lane; const size_t row = (size_t)b * SEQ + t; const int own = t0 >> 8;
    float q[64], o[64];
    loadq64(q, proj + row * LDP + C_MBQ + h * 64);
    unsigned sel = 0u;
    { float g[8];
#pragma unroll
      for (int n = 0; n < 8; ++n) { const float* km = kmean + ((size_t)(b * 4 + h) * 8 + n) * 64; float a = 0.f;
#pragma unroll
          for (int d = 0; d < 64; ++d) a = fmaf(q[d], km[d], a);
          g[n] = a; }
      for (int r = 0; r < 3; ++r) { int best = -1; float bv = -3.0e38f;
#pragma unroll
          for (int n = 0; n < 8; ++n) if (n < own && !((sel >> n) & 1u) && g[n] > bv) { bv = g[n]; best = n; }
          if (best >= 0) sel |= 1u << best; } }
    const bf16_t* kb = proj + (size_t)b * SEQ * LDP + C_MBK + h * 64; const bf16_t* vb = proj + (size_t)b * SEQ * LDP + C_MBV + h * 64;
    const float* btab = bt + (0 + h) * 128;
    float m = NEG_BIG;
    for (int n = 0; n <= own; ++n) {
        const bool mine = (n == own) || ((sel >> n) & 1u);
        if (!__any(mine)) continue;
        const int s1 = (n == own) ? t0 + 63 : n * 256 + 255;
        for (int s = n * 256; s <= s1; ++s) { const bool v = mine && s <= t;
            const float sc = dotq<8>(q, kb + (size_t)s * LDP) * 0.125f + btab[imin(imax(t - s, 0), 127)];
            if (v) m = fmaxf(m, sc); } }
#pragma unroll
    for (int i = 0; i < 64; ++i) o[i] = 0.f;
    float l = 0.f;
    for (int n = 0; n <= own; ++n) {
        const bool mine = (n == own) || ((sel >> n) & 1u);
        if (!__any(mine)) continue;
        const int s1 = (n == own) ? t0 + 63 : n * 256 + 255;
        for (int s = n * 256; s <= s1; ++s) { const bool v = mine && s <= t;
            const float sc = dotq<8>(q, kb + (size_t)s * LDP) * 0.125f + btab[imin(imax(t - s, 0), 127)];
            const float e = v ? expf(sc - m) : 0.f; l += e;
            axpy64(o, e, vb + (size_t)s * LDP); } }
    store64_bf16(mixed + row * DM + 256 + h * 64, o, 1.0f / fmaxf(l, TINY));
}

__device__ __forceinline__ void naive_diff(const bf16_t* proj, const float* bt, const float* subln, float lam, float post, bf16_t* mixed, int b, int h, int t0, int lane) {
    const int t = t0 + lane; const size_t row = (size_t)b * SEQ + t;
    float q[64], o[64];
    loadq64(q, proj + row * LDP + C_DFQ + h * 64);
    const bf16_t* kb = proj + (size_t)b * SEQ * LDP + C_DFK + h * 64; const bf16_t* vb = proj + (size_t)b * SEQ * LDP + C_DFV + h * 64;
    const float* btab = bt + (8 + h) * 128; const float scale = 0.17677669529663687f;
    float m1 = NEG_BIG, m2 = NEG_BIG;
    for (int s = 0; s <= t0 + 63; ++s) { const bool v = s <= t; const float bia = btab[imin(imax(t - s, 0), 127)];
        const float s1 = dotq<4>(q, kb + (size_t)s * LDP) * scale + bia, s2 = dotq<4>(q + 32, kb + (size_t)s * LDP + 32) * scale + bia;
        if (v) { m1 = fmaxf(m1, s1); m2 = fmaxf(m2, s2); } }
    float l1 = 0.f, l2 = 0.f;
    for (int s = 0; s <= t0 + 63; ++s) { const bool v = s <= t; const float bia = btab[imin(imax(t - s, 0), 127)];
        const float s1 = dotq<4>(q, kb + (size_t)s * LDP) * scale + bia, s2 = dotq<4>(q + 32, kb + (size_t)s * LDP + 32) * scale + bia;
        if (v) { l1 += expf(s1 - m1); l2 += expf(s2 - m2); } }
    const float r1 = 1.0f / fmaxf(l1, TINY), r2 = lam / fmaxf(l2, TINY);
#pragma unroll
    for (int i = 0; i < 64; ++i) o[i] = 0.f;
    for (int s = 0; s <= t0 + 63; ++s) { const bool v = s <= t; const float bia = btab[imin(imax(t - s, 0), 127)];
        const float s1 = dotq<4>(q, kb + (size_t)s * LDP) * scale + bia, s2 = dotq<4>(q + 32, kb + (size_t)s * LDP + 32) * scale + bia;
        const float w = v ? (expf(s1 - m1) * r1 - expf(s2 - m2) * r2) : 0.f;
        axpy64(o, w, vb + (size_t)s * LDP); }
    float ss = 0.f;
#pragma unroll
    for (int i = 0; i < 64; ++i) ss = fmaf(o[i], o[i], ss);
    const float rs = post / sqrtf(ss * (1.0f / 64.0f) + 1e-6f);
#pragma unroll
    for (int i = 0; i < 64; ++i) o[i] *= subln[i];
    store64_bf16(mixed + row * DM + 768 + h * 64, o, rs);
}

__device__ __forceinline__ void axpy32(float* o, float p, const bf16_t* row) {
    const uint4* v = (const uint4*)row;
#pragma unroll
    for (int c = 0; c < 4; ++c) { const uint4 w = v[c];
        o[8 * c + 0] = fmaf(p, bflo(w.x), o[8 * c + 0]); o[8 * c + 1] = fmaf(p, bfhi(w.x), o[8 * c + 1]); o[8 * c + 2] = fmaf(p, bflo(w.y), o[8 * c + 2]); o[8 * c + 3] = fmaf(p, bfhi(w.y), o[8 * c + 3]);
        o[8 * c + 4] = fmaf(p, bflo(w.z), o[8 * c + 4]); o[8 * c + 5] = fmaf(p, bfhi(w.z), o[8 * c + 5]); o[8 * c + 6] = fmaf(p, bflo(w.w), o[8 * c + 6]); o[8 * c + 7] = fmaf(p, bfhi(w.w), o[8 * c + 7]); }
}
__device__ __forceinline__ void naive_nsa(const bf16_t* proj, const bf16_t* kc, const bf16_t* vc, const float* bt, float* tmp, bf16_t* mixed, LAS float* imp, int b, int h, int t0, int lane) {
    const int t = t0 + lane; const size_t row = (size_t)b * SEQ + t; const int own = t0 >> 6;
    const int ncv = t >= 31 ? imin(((t - 31) >> 4) + 1, N_CMP) : 0;
    const int ncw = imin(((t0 + 63 - 31) >> 4) + 1, N_CMP);
    const bf16_t* kcb = kc + (size_t)b * 128 * 64; const bf16_t* vcb = vc + (size_t)b * 128 * 64;
    float* trow = tmp + (row * 4 + h) * 64;
    float q[64];
#pragma unroll
    for (int j = 0; j < 32; ++j) imp[j * 512] = 0.f;
    float mh = NEG_BIG, rlh = 0.f;
#pragma unroll 1
    for (int hh = 0; hh < 4; ++hh) {
        loadq64(q, proj + row * LDP + C_NSQ + hh * 64);
        const float* btab = bt + (4 + hh) * 128;
        float m = NEG_BIG;
#pragma unroll 1
        for (int c = 0; c < ncw; ++c) { const float sc = dotq<8>(q, kcb + c * 64) * 0.125f + btab[imin(imax(t - (16 * c + 31), 0), 127)]; if (c < ncv) m = fmaxf(m, sc); }
        float l = 0.f;
#pragma unroll 1
        for (int c = 0; c < ncw; ++c) { const float sc = dotq<8>(q, kcb + c * 64) * 0.125f + btab[imin(imax(t - (16 * c + 31), 0), 127)]; if (c < ncv) l += expf(sc - m); }
        const float rl = 1.0f / fmaxf(l, TINY);
        if (hh == h) { mh = m; rlh = rl; }
#pragma unroll 1
        for (int c = 0; c < ncw; ++c) { const float sc = dotq<8>(q, kcb + c * 64) * 0.125f + btab[imin(imax(t - (16 * c + 31), 0), 127)];
            const float p = (c < ncv) ? expf(sc - m) * rl : 0.f;
            const int j = c >> 2;
            if ((c & 3) == 3) { imp[j * 512] += 0.5f * p; if (j + 1 < 32) imp[(j + 1) * 512] += 0.5f * p; } else imp[j * 512] += p; }
    }
    unsigned sel = 1u << own;
    for (int r = 0; r < 3; ++r) { int best = -1; float bv = -3.0e38f;
        for (int j = 0; j < own; ++j) { const float v = imp[j * 512]; if (!((sel >> j) & 1u) && v > bv) { bv = v; best = j; } }
        if (best >= 0) sel |= 1u << best; }
    loadq64(q, proj + row * LDP + C_NSQ + h * 64);
    const float* btab = bt + (4 + h) * 128;
    const bf16_t* grow = proj + row * LDP + C_NSG;
    const float g0 = 1.0f / (1.0f + expf(-__uint_as_float((unsigned)grow[0 * 4 + h] << 16))), g1 = 1.0f / (1.0f + expf(-__uint_as_float((unsigned)grow[1 * 4 + h] << 16))),
                g2 = 1.0f / (1.0f + expf(-__uint_as_float((unsigned)grow[2 * 4 + h] << 16)));
    const bf16_t* ksb = proj + (size_t)b * SEQ * LDP + C_NKS; const bf16_t* vsb = proj + (size_t)b * SEQ * LDP + C_NVS;
    const bf16_t* kwb = proj + (size_t)b * SEQ * LDP + C_NKW; const bf16_t* vwb = proj + (size_t)b * SEQ * LDP + C_NVW;
    float ms = NEG_BIG, ls = 0.f, mw = NEG_BIG, lw = 0.f;
#pragma unroll 1
    for (int j = 0; j <= own; ++j) { const bool mine = (sel >> j) & 1u; if (!__any(mine)) continue;
#pragma unroll 1
        for (int s = j * 64; s < j * 64 + 64; ++s) { const float sc = dotq<8>(q, ksb + (size_t)s * LDP) * 0.125f + btab[imin(imax(t - s, 0), 127)]; if (mine && s <= t) ms = fmaxf(ms, sc); } }
#pragma unroll 1
    for (int j = 0; j <= own; ++j) { const bool mine = (sel >> j) & 1u; if (!__any(mine)) continue;
#pragma unroll 1
        for (int s = j * 64; s < j * 64 + 64; ++s) { const float sc = dotq<8>(q, ksb + (size_t)s * LDP) * 0.125f + btab[imin(imax(t - s, 0), 127)]; if (mine && s <= t) ls += expf(sc - ms); } }
    const int sw0 = imax(t0 - 511, 0);
#pragma unroll 1
    for (int s = sw0; s <= t0 + 63; ++s) { const float sc = dotq<8>(q, kwb + (size_t)s * LDP) * 0.125f + btab[imin(imax(t - s, 0), 127)]; if (s <= t && t - s < 512) mw = fmaxf(mw, sc); }
#pragma unroll 1
    for (int s = sw0; s <= t0 + 63; ++s) { const float sc = dotq<8>(q, kwb + (size_t)s * LDP) * 0.125f + btab[imin(imax(t - s, 0), 127)]; if (s <= t && t - s < 512) lw += expf(sc - mw); }
    const float rs = g1 / fmaxf(ls, TINY), rw = g2 / fmaxf(lw, TINY), rc = g0 * rlh;
#pragma unroll 1
    for (int half = 0; half < 2; ++half) {
        float o[32];
#pragma unroll
        for (int i = 0; i < 32; ++i) o[i] = 0.f;
#pragma unroll 1
        for (int c = 0; c < ncw; ++c) { const float sc = dotq<8>(q, kcb + c * 64) * 0.125f + btab[imin(imax(t - (16 * c + 31), 0), 127)];
            const float p = (c < ncv) ? expf(sc - mh) * rc : 0.f; axpy32(o, p, vcb + c * 64 + half * 32); }
#pragma unroll 1
        for (int j = 0; j <= own; ++j) { const bool mine = (sel >> j) & 1u; if (!__any(mine)) continue;
#pragma unroll 1
            for (int s = j * 64; s < j * 64 + 64; ++s) { const float sc = dotq<8>(q, ksb + (size_t)s * LDP) * 0.125f + btab[imin(imax(t - s, 0), 127)];
                const float e = (mine && s <= t) ? expf(sc - ms) * rs : 0.f; axpy32(o, e, vsb + (size_t)s * LDP + half * 32); } }
#pragma unroll 1
        for (int s = sw0; s <= t0 + 63; ++s) { const float sc = dotq<8>(q, kwb + (size_t)s * LDP) * 0.125f + btab[imin(imax(t - s, 0), 127)];
            const float e = (s <= t && t - s < 512) ? expf(sc - mw) * rw : 0.f; axpy32(o, e, vwb + (size_t)s * LDP + half * 32); }
        bf16_t* dst = mixed + row * DM + 512 + h * 64 + half * 32;
#pragma unroll
        for (int c = 0; c < 4; ++c) { u32x4 w; w.x = pk2(o[8 * c], o[8 * c + 1]); w.y = pk2(o[8 * c + 2], o[8 * c + 3]); w.z = pk2(o[8 * c + 4], o[8 * c + 5]); w.w = pk2(o[8 * c + 6], o[8 * c + 7]);
            *(u32x4*)(dst + 8 * c) = w; }
    }
    (void)trow;
}

namespace at {
typedef short bf16x8 __attribute__((ext_vector_type(8)));
typedef short s16x4 __attribute__((ext_vector_type(4)));
typedef float f32x16 __attribute__((ext_vector_type(16)));
constexpr int NSLOT = 5, SLOT_B = 16384, SLOT_V = 8192;
constexpr int L_BIAS = NSLOT * SLOT_B;
constexpr int BEXT = 288;
constexpr int L_MISC = L_BIAS + 2 * 12 * BEXT * 4;
constexpr float LOG2E = 1.4426950408889634f;
#define MFMA32(a, b, c) __builtin_amdgcn_mfma_f32_32x32x16_bf16((a), (b), (c), 0, 0, 0)
__device__ __forceinline__ int crow(int i, int hi) { return (i & 3) + 8 * (i >> 2) + 4 * hi; }
__device__ __forceinline__ s16x4 vtr(const LAS unsigned char* p) { typedef short v4i16_t __attribute__((ext_vector_type(4))); return __builtin_bit_cast(s16x4, __builtin_amdgcn_ds_read_tr16_b64_v4i16((LAS v4i16_t*)p)); }
__device__ __forceinline__ unsigned cvtpk(float lo, float hi) { typedef float f2 __attribute__((ext_vector_type(2))); typedef __bf16 b2 __attribute__((ext_vector_type(2))); f2 v = {lo, hi}; b2 b = __builtin_convertvector(v, b2); return __builtin_bit_cast(unsigned, b); }
__device__ __forceinline__ bf16x8 pack8(const f32x16& p, int s) { u32x4 w; w.x = cvtpk(p[8 * s], p[8 * s + 1]); w.y = cvtpk(p[8 * s + 2], p[8 * s + 3]); w.z = cvtpk(p[8 * s + 4], p[8 * s + 5]); w.w = cvtpk(p[8 * s + 6], p[8 * s + 7]); return __builtin_bit_cast(bf16x8, w); }
__device__ __forceinline__ float xhalf(float v) { return __shfl_xor(v, 32); }
__device__ __forceinline__ void glds16(const void* gsrc, unsigned lds_dst) { unsigned keep;
    asm volatile("s_mov_b32 %0, m0\n\ts_mov_b32 m0, %2\n\ts_nop 0\n\tglobal_load_lds_dwordx4 %1, off\n\ts_mov_b32 m0, %0" : "=&s"(keep) : "v"(gsrc), "s"(lds_dst) : "memory"); }
template <int PITCH = LDP> __device__ __forceinline__ void dma_tile(const bf16_t* kbase, const bf16_t* vbase, int s0, LAS unsigned char* lds, int slot, int wave, int lane) {
    const unsigned dst = (unsigned)(uintptr_t)lds + (unsigned)(slot * SLOT_B + wave * 1024);
    glds16(kbase + (size_t)(s0 + lane) * PITCH + wave * 8, (unsigned)__builtin_amdgcn_readfirstlane((int)dst));
    glds16(vbase + (size_t)(s0 + 16 * (wave & 3) + (lane >> 2)) * PITCH + (wave >> 2) * 32 + (lane & 3) * 8, (unsigned)__builtin_amdgcn_readfirstlane((int)(dst + SLOT_V)));
}
#define WAIT_BAR(N) asm volatile("s_waitcnt vmcnt(" #N ") lgkmcnt(0)\n\ts_barrier" ::: "memory")
#define END_STEP3(i, n) do { if ((i) + 3 < (n)) WAIT_BAR(4); else if ((i) + 2 < (n)) WAIT_BAR(2); else WAIT_BAR(0); } while (0)
#define END_STEP(i, n) do { if ((i) + 4 < (n)) WAIT_BAR(4); else if ((i) + 3 < (n)) WAIT_BAR(2); else WAIT_BAR(0); } while (0)
template <int D0, int ND> __device__ __forceinline__ void qk(f32x16& p0, f32x16& p1, const LAS unsigned char* kb, const bf16x8 (&q)[4], int lane) {
    const LAS unsigned char* a = kb + (lane >> 5) * 1024 + (lane & 31) * 16;
    constexpr int NB = ND > 2 ? 2 : ND;
#pragma unroll
    for (int d1 = 0; d1 < ND; d1 += NB) {
        bf16x8 kf[2 * NB];
#pragma unroll
        for (int d = 0; d < NB; ++d) { kf[2 * d] = *(const LAS bf16x8*)(a + (D0 + d1 + d) * 2048); kf[2 * d + 1] = *(const LAS bf16x8*)(a + (D0 + d1 + d) * 2048 + 512); }
        __builtin_amdgcn_sched_barrier(0);
#pragma unroll
        for (int d = 0; d < NB; ++d) { p0 = MFMA32(kf[2 * d], q[D0 + d1 + d], p0); p1 = MFMA32(kf[2 * d + 1], q[D0 + d1 + d], p1); }
    }
}
__device__ __forceinline__ void pv(f32x16 (&o)[2], const LAS unsigned char* vb, const bf16x8 (&pk)[4], int lane) {
    const int i16 = lane & 15, hi = lane >> 5;
    const LAS unsigned char* base = vb + (4 * hi + (i16 >> 2)) * 64 + ((lane >> 4) & 1) * 32 + (i16 & 3) * 8;
#pragma unroll
    for (int half = 0; half < 2; ++half) {
        s16x4 lo[4], hh[4];
#pragma unroll
        for (int s2 = 0; s2 < 2; ++s2)
#pragma unroll
            for (int db = 0; db < 2; ++db) { const int s = 2 * half + s2; lo[2 * s2 + db] = vtr(base + db * 4096 + s * 1024); hh[2 * s2 + db] = vtr(base + db * 4096 + s * 1024 + 512); }
        __builtin_amdgcn_sched_barrier(0);
#pragma unroll
        for (int s2 = 0; s2 < 2; ++s2)
#pragma unroll
            for (int db = 0; db < 2; ++db) { const s16x4 l = lo[2 * s2 + db], h = hh[2 * s2 + db];
                const bf16x8 vf = {l[0], l[1], l[2], l[3], h[0], h[1], h[2], h[3]};
                o[db] = MFMA32(vf, pk[2 * half + s2], o[db]); }
    }
}
__device__ __forceinline__ void osm(f32x16& p0, f32x16& p1, float& m, float& l, f32x16 (&o)[2]) {
    float mx = fmaxf(p0[0], p1[0]);
#pragma unroll
    for (int i = 1; i < 16; ++i) mx = fmaxf(mx, fmaxf(p0[i], p1[i]));
    mx = fmaxf(mx, xhalf(mx));
    const float mn = fmaxf(m, mx);
    if (__any(mn > m)) { const float al = __builtin_amdgcn_exp2f(m - mn); l *= al;
#pragma unroll
        for (int i = 0; i < 16; ++i) { o[0][i] *= al; o[1][i] *= al; }
        m = mn; }
    float s = 0.f;
#pragma unroll
    for (int i = 0; i < 16; ++i) { p0[i] = __builtin_amdgcn_exp2f(p0[i] - m); p1[i] = __builtin_amdgcn_exp2f(p1[i] - m); s += p0[i] + p1[i]; }
    l += s;
}
template <bool CAUSAL> __device__ __forceinline__ void bias_mask(f32x16& p0, f32x16& p1, float c2, const LAS float* b2e, int tq, int s0, int hi, bool near, bool diag) {
    if (!near) { const float bc = b2e[64 + 127];
#pragma unroll
        for (int i = 0; i < 16; ++i) { p0[i] = fmaf(p0[i], c2, bc); p1[i] = fmaf(p1[i], c2, bc); }
    } else {
        const int rel = tq - s0 - 4 * hi;
        const LAS float* bp = b2e + (rel + 64 - 63);
#pragma unroll
        for (int i = 0; i < 16; ++i) { const int k0 = (i & 3) + 8 * (i >> 2);
            p0[i] = fmaf(p0[i], c2, bp[63 - k0]); p1[i] = fmaf(p1[i], c2, bp[63 - k0 - 32]); }
        if (CAUSAL && diag) {
#pragma unroll
            for (int i = 0; i < 16; ++i) { const int k0 = (i & 3) + 8 * (i >> 2);
                if (rel < k0) p0[i] = -INFINITY; if (rel < k0 + 32) p1[i] = -INFINITY; } }
    }
}

constexpr float SM_THR = 8.0f;
__device__ __forceinline__ float max32(const f32x16& p0, const f32x16& p1) {
    float a = fmaxf(fmaxf(p0[0], p0[1]), p1[0]), b = fmaxf(fmaxf(p0[2], p0[3]), p1[1]); a = fmaxf(fmaxf(a, p1[2]), p1[3]);
#pragma unroll
    for (int r = 4; r < 16; r += 4) { a = fmaxf(fmaxf(a, p0[r]), p0[r + 1]); b = fmaxf(fmaxf(b, p0[r + 2]), p0[r + 3]); a = fmaxf(fmaxf(a, p1[r]), p1[r + 1]); b = fmaxf(fmaxf(b, p1[r + 2]), p1[r + 3]); }
    return fmaxf(a, b);
}
template <bool LANEMASK, bool LOWER> __device__ __forceinline__ void soft(f32x16& p0, f32x16& p1, float c2, const LAS float* b2e, int rel, bool near, bool diag, bool mine, bool low, int r1,
                                                                          float& m, float& l, f32x16 (&o)[2]) {
    const float bc = b2e[64 + 127];
    if (near) {
        const LAS float* bp = b2e + 12 * BEXT + (rel + 64 - 63);
#pragma unroll
        for (int i = 0; i < 16; ++i) { const int k0 = (i & 3) + 8 * (i >> 2); p0[i] += bp[63 - k0]; p1[i] += bp[63 - k0 - 32]; }
        if (diag) {
#pragma unroll
            for (int i = 0; i < 16; ++i) { const int k0 = (i & 3) + 8 * (i >> 2); if (rel < k0) p0[i] = -INFINITY; if (rel < k0 + 32) p1[i] = -INFINITY; } }
    }
    if (LOWER && low) {
#pragma unroll
        for (int i = 0; i < 16; ++i) { const int k0 = (i & 3) + 8 * (i >> 2); if (k0 < r1) p0[i] = -INFINITY; if (k0 + 32 < r1) p1[i] = -INFINITY; } }
    float tm = max32(p0, p1); tm = fmaxf(tm, xhalf(tm)); tm = fmaf(tm, c2, bc);
    if (LANEMASK && !mine) tm = -INFINITY;
    const float mn = tm > m + SM_THR ? tm : m, al = __builtin_amdgcn_exp2f(m - mn);
    m = mn; l *= al;
#pragma unroll
    for (int i = 0; i < 16; ++i) { o[0][i] *= al; o[1][i] *= al; }
    float off = bc - m; if (LANEMASK && !mine) off = -INFINITY;
    float s = 0.f;
#pragma unroll
    for (int i = 0; i < 16; ++i) { p0[i] = __builtin_amdgcn_exp2f(fmaf(p0[i], c2, off)); p1[i] = __builtin_amdgcn_exp2f(fmaf(p1[i], c2, off)); s += p0[i] + p1[i]; }
    l += s;
}
template <int D0, int ND> __device__ __forceinline__ void qk_issue(f32x16& p0, f32x16& p1, const LAS unsigned char* kb, const bf16x8 (&q)[4], int lane) {
#pragma unroll
    for (int i = 0; i < 16; ++i) { p0[i] = 0.f; p1[i] = 0.f; }
    qk<D0, ND>(p0, p1, kb, q, lane);
}
#define SOFT_PV(LM, LW, P0, P1, VB, O, M, L, NEAR, DIAG, MINE, LOW, R1) do { soft<LM, LW>(P0, P1, c2, b2, tq - s0_ - 4 * hi, NEAR, DIAG, MINE, LOW, R1, M, L, O); \
    bf16x8 pk_[4] = {pack8(P0, 0), pack8(P0, 1), pack8(P1, 0), pack8(P1, 1)}; pv(O, VB, pk_, lane); } while (0)

template <int D0, int ND, bool LM> __device__ __forceinline__ void causal_pass(const bf16_t* kbase, const bf16_t* vbase, LAS unsigned char* lds, const bf16x8 (&q)[4], float c2, const LAS float* b2,
        int tq, int tq0, int hi, int lane, int wave, int nt, int own, unsigned sel, float& m, float& l, f32x16 (&o)[2]) {
#pragma unroll
    for (int k = 0; k < 4; ++k) if (k < nt) dma_tile(kbase, vbase, 64 * k, lds, k, wave, lane);
    END_STEP(-1, nt);
    f32x16 sc0, sc1, sn0, sn1;
    qk_issue<D0, ND>(sc0, sc1, lds, q, lane);
    int sl = 0, sl4 = 4;
#define MB_STEP(C0, C1, N0, N1, j) do { \
        const LAS unsigned char* vb = lds + sl * SLOT_B + SLOT_V; const int sn = sl == NSLOT - 1 ? 0 : sl + 1; \
        if ((j) + 4 < nt) dma_tile(kbase, vbase, 64 * ((j) + 4), lds, sl4, wave, lane); \
        qk_issue<D0, ND>(N0, N1, lds + ((j) + 1 < nt ? sn : sl) * SLOT_B, q, lane); __builtin_amdgcn_sched_barrier(0);     \
        { const int s0_ = 64 * (j), nb = (j) >> 2; const bool mine = nb >= own || ((sel >> nb) & 1u); \
          SOFT_PV(LM, false, C0, C1, vb, o, m, l, (tq0 - (s0_ + 63)) < 113, (s0_ + 63) > tq0, mine, false, 0); __builtin_amdgcn_sched_barrier(0); } \
        END_STEP(j, nt); \
        sl = sn; sl4 = sl4 == NSLOT - 1 ? 0 : sl4 + 1; } while (0)
    for (int j = 0; j < nt; j += 2) { MB_STEP(sc0, sc1, sn0, sn1, j); MB_STEP(sn0, sn1, sc0, sc1, j + 1); }
#undef MB_STEP
}

__device__ __forceinline__ void diff_unit(const bf16_t* proj, const float* subln, float lam, float post, bf16_t* mixed, LAS unsigned char* lds, int b, int h, int qb) {
    const int tid = opq_tid(), lane = tid & 63, wave = __builtin_amdgcn_readfirstlane(tid >> 6), hi = lane >> 5;
    const int tq0 = qb * 256 + wave * 32, tq = tq0 + (lane & 31);
    const bf16_t* kbase = proj + (size_t)b * SEQ * LDP + C_DFK + h * 64; const bf16_t* vbase = proj + (size_t)b * SEQ * LDP + C_DFV + h * 64;
    const LAS float* b2 = (const LAS float*)(lds + L_BIAS) + (8 + h) * BEXT;
    bf16x8 q[4];
    { const bf16_t* qrow = proj + ((size_t)b * SEQ + tq) * LDP + C_DFQ + h * 64 + hi * 8;
#pragma unroll
      for (int d0 = 0; d0 < 4; ++d0) q[d0] = *(const bf16x8*)(qrow + d0 * 16); }
    const float c2 = 0.17677669529663687f * LOG2E;
    float m1 = -1e30f, m2 = -1e30f, l1 = 0.f, l2 = 0.f; f32x16 o1[2], o2[2];
#pragma unroll
    for (int i = 0; i < 16; ++i) { o1[0][i] = 0.f; o1[1][i] = 0.f; o2[0][i] = 0.f; o2[1][i] = 0.f; }
    causal_pass<0, 2, false>(kbase, vbase, lds, q, c2, b2, tq, tq0, hi, lane, wave, 4 * (qb + 1), 0, 0u, m1, l1, o1);
    l1 += xhalf(l1);
    { const float r1 = 1.0f / fmaxf(l1, TINY);
#pragma unroll
      for (int i = 0; i < 16; ++i) { o1[0][i] *= r1; o1[1][i] *= r1; } }
    causal_pass<2, 2, false>(kbase, vbase, lds, q, c2, b2, tq, tq0, hi, lane, wave, 4 * (qb + 1), 0, 0u, m2, l2, o2);
    l2 += xhalf(l2);
    const float r1 = 1.0f, r2 = lam / fmaxf(l2, TINY);
    float ss = 0.f;
#pragma unroll
    for (int db = 0; db < 2; ++db)
#pragma unroll
        for (int i = 0; i < 16; ++i) { const float v = o1[db][i] * r1 - o2[db][i] * r2; o1[db][i] = v; ss = fmaf(v, v, ss); }
    ss += xhalf(ss);
    const float rs = post / sqrtf(ss * (1.0f / 64.0f) + 1e-6f);
    bf16_t* orow = mixed + ((size_t)b * SEQ + tq) * DM + 768 + h * 64;
#pragma unroll
    for (int db = 0; db < 2; ++db)
#pragma unroll
        for (int g = 0; g < 4; ++g) { const int d = 32 * db + 8 * g + 4 * hi; const f32x4 gn = *(const f32x4*)(subln + d);
            uint2 w; w.x = pk2(o1[db][4 * g] * rs * gn[0], o1[db][4 * g + 1] * rs * gn[1]); w.y = pk2(o1[db][4 * g + 2] * rs * gn[2], o1[db][4 * g + 3] * rs * gn[3]);
            *(uint2*)(orow + d) = w; }
}

__device__ __forceinline__ void store_ot(bf16_t* orow, const f32x16 (&o)[2], float sc, int hi) {
#pragma unroll
    for (int db = 0; db < 2; ++db)
#pragma unroll
        for (int g = 0; g < 4; ++g) { uint2 w; w.x = pk2(o[db][4 * g] * sc, o[db][4 * g + 1] * sc); w.y = pk2(o[db][4 * g + 2] * sc, o[db][4 * g + 3] * sc);
            *(uint2*)(orow + 32 * db + 8 * g + 4 * hi) = w; }
}

__device__ __forceinline__ void moba_unit(const bf16_t* proj, const float* kmean, bf16_t* mixed, LAS unsigned char* lds, int b, int h, int own) {
    const int tid = opq_tid(), lane = tid & 63, wave = __builtin_amdgcn_readfirstlane(tid >> 6), hi = lane >> 5;
    const int tq0 = own * 256 + wave * 32, tq = tq0 + (lane & 31);
    const bf16_t* kbase = proj + (size_t)b * SEQ * LDP + C_MBK + h * 64; const bf16_t* vbase = proj + (size_t)b * SEQ * LDP + C_MBV + h * 64;
    const LAS float* b2 = (const LAS float*)(lds + L_BIAS) + (0 + h) * BEXT;
    bf16x8 q[4];
    { const bf16_t* qrow = proj + ((size_t)b * SEQ + tq) * LDP + C_MBQ + h * 64 + hi * 8;
#pragma unroll
      for (int d0 = 0; d0 < 4; ++d0) q[d0] = *(const bf16x8*)(qrow + d0 * 16); }
    unsigned sel = 0u;
    { float g[7];
#pragma unroll
      for (int n = 0; n < 7; ++n) { float a = 0.f;
          if (n < own) { const float* km = kmean + ((size_t)(b * 4 + h) * 8 + n) * 64 + hi * 8;
#pragma unroll
              for (int d0 = 0; d0 < 4; ++d0) { const f32x4 k0 = *(const f32x4*)(km + d0 * 16), k1 = *(const f32x4*)(km + d0 * 16 + 4); const u32x4 qw = __builtin_bit_cast(u32x4, q[d0]);
                  a = fmaf(bflo(qw.x), k0[0], a); a = fmaf(bfhi(qw.x), k0[1], a); a = fmaf(bflo(qw.y), k0[2], a); a = fmaf(bfhi(qw.y), k0[3], a);
                  a = fmaf(bflo(qw.z), k1[0], a); a = fmaf(bfhi(qw.z), k1[1], a); a = fmaf(bflo(qw.w), k1[2], a); a = fmaf(bfhi(qw.w), k1[3], a); } }
          g[n] = a + xhalf(a); }
#pragma unroll
      for (int r = 0; r < 3; ++r) { int best = -1; float bv = -3.0e38f;
#pragma unroll
          for (int n = 0; n < 7; ++n) if (n < own && !((sel >> n) & 1u) && g[n] > bv) { bv = g[n]; best = n; }
          if (best >= 0) sel |= 1u << best; } }
    const float c2 = 0.125f * LOG2E;
    float m = -1e30f, l = 0.f; f32x16 o[2];
#pragma unroll
    for (int i = 0; i < 16; ++i) { o[0][i] = 0.f; o[1][i] = 0.f; }
    causal_pass<0, 4, true>(kbase, vbase, lds, q, c2, b2, tq, tq0, hi, lane, wave, 4 * (own + 1), own, sel, m, l, o);
    l += xhalf(l);
    store_ot(mixed + ((size_t)b * SEQ + tq) * DM + 256 + h * 64, o, 1.0f / fmaxf(l, TINY), hi);
}

constexpr int L_IMP = L_MISC, L_WM = L_IMP + 4 * 64 * 33 * 4, L_NSA_END = L_WM + 64;
__device__ __forceinline__ void nsa_unit(const bf16_t* proj, const bf16_t* kc, const bf16_t* vc, bf16_t* mixed, LAS unsigned char* lds, int b, int own) {
    const int tid = opq_tid(), lane = tid & 63, wave = __builtin_amdgcn_readfirstlane(tid >> 6), hi = lane >> 5, hd = wave >> 1, qs = wave & 1;
    const int t0 = own * 64, tq0 = t0 + qs * 32, ql = qs * 32 + (lane & 31), tq = t0 + ql;
    const LAS float* b2 = (const LAS float*)(lds + L_BIAS) + (4 + hd) * BEXT;
    LAS float* IMP = (LAS float*)(lds + L_IMP); LAS unsigned* WM = (LAS unsigned*)(lds + L_WM);
    const size_t rowq = (size_t)b * SEQ + tq;
    bf16x8 q[4];
    { const bf16_t* qrow = proj + rowq * LDP + C_NSQ + hd * 64 + hi * 8;
#pragma unroll
      for (int d0 = 0; d0 < 4; ++d0) q[d0] = *(const bf16x8*)(qrow + d0 * 16); }
    const float c2 = 0.125f * LOG2E;
    f32x16 acc[2];
    {
        const bf16_t* kcb = kc + (size_t)b * 128 * 64; const bf16_t* vcb = vc + (size_t)b * 128 * 64;
        const bool two = (imin(((t0 + 32) >> 4) + 1, N_CMP)) > 64;
        dma_tile<64>(kcb, vcb, 0, lds, 0, wave, lane);
        if (two) dma_tile<64>(kcb, vcb, 64, lds, 1, wave, lane);
        WAIT_BAR(0);
        f32x16 p[4];
#pragma unroll
        for (int e = 0; e < 4; ++e)
#pragma unroll
            for (int i = 0; i < 16; ++i) p[e][i] = 0.f;
        qk<0, 4>(p[0], p[1], lds, q, lane);
        if (two) qk<0, 4>(p[2], p[3], lds + SLOT_B, q, lane);
        float mx = -INFINITY;
#pragma unroll
        for (int e = 0; e < 4; ++e)
#pragma unroll
            for (int i = 0; i < 16; ++i) { const int c = 32 * e + crow(i, hi), dist = tq - 31 - 16 * c;
                const float v = dist >= 0 ? fmaf(p[e][i], c2, b2[64 + imin(imax(dist, 0), 127)]) : -INFINITY; p[e][i] = v; mx = fmaxf(mx, v); }
        mx = fmaxf(mx, xhalf(mx)); const float ms = (mx == -INFINITY) ? 0.f : mx;
        float sum = 0.f;
#pragma unroll
        for (int e = 0; e < 4; ++e)
#pragma unroll
            for (int i = 0; i < 16; ++i) { p[e][i] = __builtin_amdgcn_exp2f(p[e][i] - ms); sum += p[e][i]; }
        sum += xhalf(sum); const float rl = 1.0f / fmaxf(sum, TINY);
#pragma unroll
        for (int e = 0; e < 4; ++e)
#pragma unroll
            for (int i = 0; i < 16; ++i) p[e][i] *= rl;
#pragma unroll
        for (int i = 0; i < 16; ++i) { acc[0][i] = 0.f; acc[1][i] = 0.f; }
        { bf16x8 pk[4] = {pack8(p[0], 0), pack8(p[0], 1), pack8(p[1], 0), pack8(p[1], 1)}; pv(acc, lds + SLOT_V, pk, lane); }
        if (two) { bf16x8 pk[4] = {pack8(p[2], 0), pack8(p[2], 1), pack8(p[3], 0), pack8(p[3], 1)}; pv(acc, lds + SLOT_B + SLOT_V, pk, lane); }
        float part[16], sp[16];
#pragma unroll
        for (int e = 0; e < 16; ++e) { const f32x16& P = p[e >> 2]; const int m4 = e & 3; sp[e] = 0.5f * P[4 * m4 + 3]; part[e] = (P[4 * m4] + P[4 * m4 + 1]) + (P[4 * m4 + 2] + sp[e]); }
        LAS float* irow = IMP + (hd * 64 + ql) * 33 + hi;
        float prev = 0.f;
#pragma unroll
        for (int e = 0; e < 16; ++e) { const float xo = xhalf(sp[e]); const float recv = hi ? xo : prev; prev = xo; irow[2 * e] = part[e] + recv; }
        const float g0 = 1.0f / (1.0f + __expf(-__uint_as_float((unsigned)proj[rowq * LDP + C_NSG + 0 * 4 + hd] << 16)));
#pragma unroll
        for (int i = 0; i < 16; ++i) { acc[0][i] *= g0; acc[1][i] *= g0; }
    }
    __syncthreads();
    unsigned sel = 1u << own;
    { float v1 = -3.0e38f, v2 = -3.0e38f, v3 = -3.0e38f; int i1 = -1, i2 = -1, i3 = -1;
      const LAS float* ir = IMP + ql * 33;
#pragma unroll 1
      for (int j = 0; j < own; ++j) { const float v = ((ir[j] + ir[64 * 33 + j]) + ir[2 * 64 * 33 + j]) + ir[3 * 64 * 33 + j];
          if (v > v1) { v3 = v2; i3 = i2; v2 = v1; i2 = i1; v1 = v; i1 = j; } else if (v > v2) { v3 = v2; i3 = i2; v2 = v; i2 = j; } else if (v > v3) { v3 = v; i3 = j; } }
      if (i1 >= 0) sel |= 1u << i1; if (i2 >= 0) sel |= 1u << i2; if (i3 >= 0) sel |= 1u << i3; }
    unsigned bm;
    { unsigned wm = sel;
#pragma unroll
      for (int o = 1; o < 64; o <<= 1) wm |= (unsigned)__shfl_xor((int)wm, o);
      if (lane == 0) WM[wave] = wm;
      __syncthreads();
      bm = WM[0] | WM[1] | WM[2] | WM[3] | WM[4] | WM[5] | WM[6] | WM[7]; }
#pragma unroll 1
    for (int br = 1; br <= 2; ++br) {
        const bf16_t* kbase = proj + (size_t)b * SEQ * LDP + (br == 1 ? C_NKS : C_NKW); const bf16_t* vbase = proj + (size_t)b * SEQ * LDP + (br == 1 ? C_NVS : C_NVW);
        unsigned rem = br == 1 ? bm : (((own >= 8 ? 0x1ffu << (own - 8) : 0x1ffu >> (8 - own))) & ((2u << own) - 1u));
        float m = -1e30f, l = 0.f; f32x16 o[2];
#pragma unroll
        for (int i = 0; i < 16; ++i) { o[0][i] = 0.f; o[1][i] = 0.f; }
        const int n = __popc(rem); unsigned iss = rem;
#pragma unroll
        for (int k = 0; k < 4; ++k) if (iss) { const int t = __ffs((int)iss) - 1; iss &= iss - 1u; dma_tile(kbase, vbase, 64 * t, lds, k, wave, lane); }
        END_STEP(-1, n);
        f32x16 sc0, sc1, sn0, sn1;
        int jc = __ffs((int)rem) - 1; rem &= rem - 1u;
        qk_issue<0, 4>(sc0, sc1, lds, q, lane);
        int sl = 0, sl4 = 4;
#define NS_STEP(C0, C1, N0, N1, i) do { \
            const LAS unsigned char* vb = lds + sl * SLOT_B + SLOT_V; const int sn = sl == NSLOT - 1 ? 0 : sl + 1; \
            if (iss) { const int t = __ffs((int)iss) - 1; iss &= iss - 1u; dma_tile(kbase, vbase, 64 * t, lds, sl4, wave, lane); } \
            const int jn = rem ? __ffs((int)rem) - 1 : -1; rem &= rem - 1u; \
            qk_issue<0, 4>(N0, N1, lds + (jn >= 0 ? sn : sl) * SLOT_B, q, lane); __builtin_amdgcn_sched_barrier(0); \
            { const int s0_ = 64 * jc; const bool mine = br == 2 || ((sel >> jc) & 1u); \
              SOFT_PV(true, true, C0, C1, vb, o, m, l, (tq0 - (s0_ + 63)) < 113, jc == own, mine, br == 2 && jc == own - 8, ql + 1 - 4 * hi); __builtin_amdgcn_sched_barrier(0); } \
            END_STEP(i, n); \
            jc = jn; sl = sn; sl4 = sl4 == NSLOT - 1 ? 0 : sl4 + 1; } while (0)
        for (int i = 0; i < n; i += 2) { NS_STEP(sc0, sc1, sn0, sn1, i); if (i + 1 < n) NS_STEP(sn0, sn1, sc0, sc1, i + 1); }
#undef NS_STEP
        l += xhalf(l);
        const float g = 1.0f / (1.0f + __expf(-__uint_as_float((unsigned)proj[rowq * LDP + C_NSG + br * 4 + hd] << 16))) / fmaxf(l, TINY);
#pragma unroll
        for (int i = 0; i < 16; ++i) { acc[0][i] = fmaf(o[0][i], g, acc[0][i]); acc[1][i] = fmaf(o[1][i], g, acc[1][i]); }
    }
    store_ot(mixed + rowq * DM + 512 + hd * 64, acc, 1.0f, hi);
}

constexpr int L_DONE = L_MISC;
__device__ __forceinline__ void sb_unit(const bf16_t* proj, bf16_t* mixed, LAS unsigned char* lds, int b, int h, int qb) {
    const int tid = opq_tid(), lane = tid & 63, wave = __builtin_amdgcn_readfirstlane(tid >> 6), hi = lane >> 5;
    const int tq0 = qb * 256 + wave * 32, tq = tq0 + (lane & 31);
    const bf16_t* kbase = proj + (size_t)b * SEQ * LDP + C_SBK + h * 64; const bf16_t* vbase = proj + (size_t)b * SEQ * LDP + C_SBV + h * 64;
    LAS unsigned* DONE = (LAS unsigned*)(lds + L_DONE);
    bf16x8 q[4];
    { const bf16_t* qrow = proj + ((size_t)b * SEQ + tq) * LDP + C_SBQ + h * 64 + hi * 8;
#pragma unroll
      for (int d0 = 0; d0 < 4; ++d0) q[d0] = *(const bf16x8*)(qrow + d0 * 16); }
    float R = 0.f; f32x16 o[2];
#pragma unroll
    for (int i = 0; i < 16; ++i) { o[0][i] = 0.f; o[1][i] = 0.f; }
    const int jtop = 4 * qb + 3, jw = 4 * qb + (wave >> 1);
    bool wdone = false;
    const int nt = jtop + 1;
#pragma unroll
    for (int k = 0; k < 3; ++k) if (k < nt) dma_tile(kbase, vbase, 64 * (jtop - k), lds, k, wave, lane);
    END_STEP3(-1, nt);
    int it = 0;
    for (int j = jtop; j >= 0; --j, ++it) {
        const LAS unsigned char* kb = lds + (it & 3) * SLOT_B; const LAS unsigned char* vb = kb + SLOT_V;
        if (it + 3 < nt) dma_tile(kbase, vbase, 64 * (j - 3), lds, (it + 3) & 3, wave, lane);
        if (j <= jw && !wdone) {
            const int s0 = 64 * j;
            f32x16 p0, p1;
#pragma unroll
            for (int i = 0; i < 16; ++i) { p0[i] = 0.f; p1[i] = 0.f; }
            qk<0, 4>(p0, p1, kb, q, lane);
            const int rel = tq - s0 - 4 * hi;
            f32x16 lk0, lk1;
#pragma unroll
            for (int i = 0; i < 16; ++i) { const int k0 = (i & 3) + 8 * (i >> 2);
                const float z0 = p0[i] * 0.125f, z1 = p1[i] * 0.125f;
                const float sp0 = fmaxf(z0, 0.f) + 0.6931471805599453f * __builtin_amdgcn_logf(1.0f + __builtin_amdgcn_exp2f(-fabsf(z0) * LOG2E));
                const float sp1 = fmaxf(z1, 0.f) + 0.6931471805599453f * __builtin_amdgcn_logf(1.0f + __builtin_amdgcn_exp2f(-fabsf(z1) * LOG2E));
                const bool v0 = k0 < rel, v1 = k0 + 32 < rel;
                lk0[i] = v0 ? -sp0 : 0.f; lk1[i] = v1 ? -sp1 : 0.f;
                p0[i] = v0 ? z0 - sp0 : -INFINITY; p1[i] = v1 ? z1 - sp1 : -INFINITY; }
            float gs[8];
#pragma unroll
            for (int e = 0; e < 8; ++e) { f32x16& L = (e < 4) ? lk0 : lk1; f32x16& P = (e < 4) ? p0 : p1; const int m4 = e & 3;
                const float x0 = L[4 * m4], x1 = L[4 * m4 + 1], x2 = L[4 * m4 + 2], x3 = L[4 * m4 + 3];
                const float w2 = x3, w1 = x3 + x2, w0 = w1 + x1; gs[e] = w0 + x0;
                P[4 * m4] += w0; P[4 * m4 + 1] += w1; P[4 * m4 + 2] += w2; }
            float above = R, tot = 0.f;
#pragma unroll
            for (int e = 7; e >= 0; --e) { f32x16& P = (e < 4) ? p0 : p1; const int m4 = e & 3;
                const float xo = xhalf(gs[e]); const float ab = above + (hi ? 0.f : xo);
                P[4 * m4] += ab; P[4 * m4 + 1] += ab; P[4 * m4 + 2] += ab; P[4 * m4 + 3] += ab;
                above += gs[e] + xo; tot += gs[e] + xo; }
            R += tot;
#pragma unroll
            for (int i = 0; i < 16; ++i) { p0[i] = __builtin_amdgcn_exp2f(p0[i] * LOG2E); p1[i] = __builtin_amdgcn_exp2f(p1[i] * LOG2E); }
            bf16x8 pk[4] = {pack8(p0, 0), pack8(p0, 1), pack8(p1, 0), pack8(p1, 1)}; pv(o, vb, pk, lane);
            wdone = __all(R < -104.f);
        }
        if (lane == 0) DONE[(it & 1) * 8 + wave] = wdone ? 1u : 0u;
        END_STEP3(it, nt);
        const LAS unsigned* dn = DONE + (it & 1) * 8;
        if ((dn[0] & dn[1] & dn[2] & dn[3] & dn[4] & dn[5] & dn[6] & dn[7]) != 0u) break;
    }
    WAIT_BAR(0);
    store_ot(mixed + ((size_t)b * SEQ + tq) * DM + 0 + h * 64, o, 1.0f, hi);
}

constexpr int CA_STR = 4112, CH_STR = 528;
__device__ __forceinline__ void compress_unit(const bf16_t* proj, int col0, const float* pos, const bf16_t* w1t, const bf16_t* w2t, bf16_t* outp, LAS unsigned char* lds, int tile) {
    const int tid = opq_tid(), lane = tid & 63, wave = __builtin_amdgcn_readfirstlane(tid >> 6), hi = lane >> 5;
    {
      const int sr = tid >> 4, r = imin(tile * 32 + sr, 8 * N_CMP - 1), rb = r / N_CMP, rc = r % N_CMP, lq = (tid & 15) >> 2, dq = (tid & 3) * 16;
      const bf16_t* src = proj + ((size_t)rb * SEQ + 16 * rc + lq) * LDP + col0 + dq;
#pragma unroll 2
      for (int ch = 0; ch < 8; ++ch) {
          const u32x4 x0 = *(const u32x4*)(src + (size_t)(4 * ch) * LDP), x1 = *(const u32x4*)(src + (size_t)(4 * ch) * LDP + 8);
          const float* pp = pos + (4 * ch + lq) * 64 + dq; const f32x4 q0 = *(const f32x4*)pp, q1 = *(const f32x4*)(pp + 4), q2 = *(const f32x4*)(pp + 8), q3 = *(const f32x4*)(pp + 12);
          u32x4 y0, y1;
          y0.x = pk2(bflo(x0.x) + q0[0], bfhi(x0.x) + q0[1]); y0.y = pk2(bflo(x0.y) + q0[2], bfhi(x0.y) + q0[3]); y0.z = pk2(bflo(x0.z) + q1[0], bfhi(x0.z) + q1[1]); y0.w = pk2(bflo(x0.w) + q1[2], bfhi(x0.w) + q1[3]);
          y1.x = pk2(bflo(x1.x) + q2[0], bfhi(x1.x) + q2[1]); y1.y = pk2(bflo(x1.y) + q2[2], bfhi(x1.y) + q2[3]); y1.z = pk2(bflo(x1.z) + q3[0], bfhi(x1.z) + q3[1]); y1.w = pk2(bflo(x1.w) + q3[2], bfhi(x1.w) + q3[3]);
          LAS unsigned char* d = lds + sr * CA_STR + ((4 * ch + lq) * 64 + dq) * 2; *(LAS u32x4*)d = y0; *(LAS u32x4*)(d + 16) = y1; } }
    __syncthreads();
    f32x16 acc;
#pragma unroll
    for (int i = 0; i < 16; ++i) acc[i] = 0.f;
    { const LAS unsigned char* ap = lds + (lane & 31) * CA_STR + hi * 16; const bf16_t* bsrc = w1t + (size_t)(wave * 32 + (lane & 31)) * 2048 + hi * 8;
#pragma unroll 16
      for (int ks = 0; ks < 128; ++ks) { const bf16x8 af = *(const LAS bf16x8*)(ap + ks * 32); const bf16x8 bfr = *(const bf16x8*)(bsrc + ks * 16); acc = MFMA32(af, bfr, acc); } }
    __syncthreads();
    { const int n = wave * 32 + (lane & 31);
#pragma unroll
      for (int i = 0; i < 16; ++i) *(LAS bf16_t*)(lds + crow(i, hi) * CH_STR + n * 2) = (bf16_t)f2bf(gelu_tanh(acc[i])); }
    __syncthreads();
    if (wave < 2) {
        f32x16 o2;
#pragma unroll
        for (int i = 0; i < 16; ++i) o2[i] = 0.f;
        const LAS unsigned char* ap = lds + (lane & 31) * CH_STR + hi * 16; const bf16_t* b2p = w2t + (size_t)(wave * 32 + (lane & 31)) * 256 + hi * 8;
#pragma unroll
        for (int ks = 0; ks < 16; ++ks) { const bf16x8 af = *(const LAS bf16x8*)(ap + ks * 32); const bf16x8 bfr = *(const bf16x8*)(b2p + ks * 16); o2 = MFMA32(af, bfr, o2); }
        const int n = wave * 32 + (lane & 31);
#pragma unroll
        for (int i = 0; i < 16; ++i) { const int rr = tile * 32 + crow(i, hi); if (rr < 8 * N_CMP) outp[((size_t)(rr / N_CMP) * 128 + rr % N_CMP) * 64 + n] = (bf16_t)f2bf(o2[i]); }
    }
    __syncthreads();
}
__device__ __forceinline__ void kmean_item(const bf16_t* proj, float* kmean, int item, int lane) {
    const int n = item & 7, bh = item >> 3, b = bh >> 2, h = bh & 3;
    const bf16_t* kb = proj + ((size_t)b * SEQ + n * 256 + (lane >> 3)) * LDP + C_MBK + h * 64 + (lane & 7) * 8;
    float a[8];
#pragma unroll
    for (int i = 0; i < 8; ++i) a[i] = 0.f;
#pragma unroll 8
    for (int i = 0; i < 32; ++i) { const u32x4 w = *(const u32x4*)(kb + (size_t)(8 * i) * LDP);
        a[0] += bflo(w.x); a[1] += bfhi(w.x); a[2] += bflo(w.y); a[3] += bfhi(w.y); a[4] += bflo(w.z); a[5] += bfhi(w.z); a[6] += bflo(w.w); a[7] += bfhi(w.w); }
#pragma unroll
    for (int i = 0; i < 8; ++i) { a[i] += __shfl_xor(a[i], 8); a[i] += __shfl_xor(a[i], 16); a[i] += __shfl_xor(a[i], 32); }
    if (lane < 8) { float* o = kmean + (size_t)item * 64 + lane * 8;
        *(f32x4*)o = (f32x4){a[0], a[1], a[2], a[3]} * (1.0f / 256.0f); *(f32x4*)(o + 4) = (f32x4){a[4], a[5], a[6], a[7]} * (1.0f / 256.0f); }
}
}

__device__ __forceinline__ void prep_kmean(const bf16_t* proj, float* kmean, LAS float* scr, int item, int tid) {
    const int n = item & 7, bh = item >> 3, b = bh >> 2, h = bh & 3, d = tid & 63, part = tid >> 6;
    const bf16_t* kb = proj + ((size_t)b * SEQ + n * 256 + part * 32) * LDP + C_MBK + h * 64 + d;
    float a = 0.f;
    for (int i = 0; i < 32; ++i) a += __uint_as_float((unsigned)kb[(size_t)i * LDP] << 16);
    scr[part * 64 + d] = a;
    __syncthreads();
    if (tid < 64) { float s = 0.f;
#pragma unroll
        for (int p = 0; p < 8; ++p) s += scr[p * 64 + tid];
        kmean[(size_t)item * 64 + tid] = s * (1.0f / 256.0f); }
    __syncthreads();
}
__device__ __forceinline__ void prep_compress_naive(const bf16_t* proj, const float* pos, const float* w1, const float* w2, bf16_t* outp, int col0, LAS float* scr, int b, int c, int tid) {
    LAS float* a = scr;
    LAS float* part = scr + 2048;
    LAS float* hid = scr + 2560;
    for (int i = tid; i < 2048; i += 512) { const int l = i >> 6, d = i & 63;
        a[i] = __uint_as_float((unsigned)proj[((size_t)b * SEQ + 16 * c + l) * LDP + col0 + d] << 16) + pos[i]; }
    __syncthreads();
    { const int j = tid & 255, kh = tid >> 8; float s = 0.f; const float* w = w1 + (size_t)kh * 1024 * 256 + j; const LAS float* ap = a + kh * 1024;
      for (int k = 0; k < 1024; ++k) s = fmaf(ap[k], w[(size_t)k * 256], s);
      part[kh * 256 + j] = s; }
    __syncthreads();
    if (tid < 256) hid[tid] = gelu_tanh(part[tid] + part[256 + tid]);
    __syncthreads();
    if (tid < 64) { float s = 0.f;
        for (int j = 0; j < 256; ++j) s = fmaf(hid[j], w2[j * 64 + tid], s);
        outp[((size_t)b * 128 + c) * 64 + tid] = (bf16_t)f2bf(s); }
    __syncthreads();
}

__global__ void __launch_bounds__(512, 2) hybrid_fwd(Args args) {
    extern __shared__ __attribute__((aligned(16))) unsigned char lds_raw[];
    cg::grid_group grid = cg::this_grid();
    LAS unsigned char* lds = (LAS unsigned char*)lds_raw;
    volatile LAS unsigned* xb_st = (volatile LAS unsigned*)(lds + LDS_BYTES - 16);
    if (threadIdx.x < 2) xb_st[threadIdx.x] = 0u;
    __syncthreads();
    if (threadIdx.x == 0) (void)xb_add(&((unsigned*)(opq(args.ws) + WS_BAR))[XB_XCNT(xb_xcc_id())], 1u);
#define XBAR() do { XcdBarrier xb_; xb_.bar = (unsigned*)(opq(args.ws) + WS_BAR); xb_.x = xb_xcc_id(); xb_.st = xb_st; xcd_barrier(xb_); } while (0)

    {
        const int tid = opq_tid(), lane = tid & 63, wave = __builtin_amdgcn_readfirstlane(tid >> 6), G = gridDim.x, bid = blockIdx.x, gw = bid * 8 + wave, NGW = G * 8;
        unsigned char* ws = opq(args.ws);
        float* rowss = (float*)(ws + WS_ROWSS); float* bt = (float*)(ws + WS_BIAS); bf16_t* xb = (bf16_t*)(ws + WS_XB);
        const float* x_in = args.in[0]; const float* rel_bias = args.in[15];
        for (int i = bid * 512 + tid; i < 4 * M_TOK; i += G * 512) rowss[M_TOK + i] = 0.f;
        for (int i = bid * 512 + tid; i < 12 * 128; i += G * 512) { const int col = i >> 7, d = i & 127; bt[i] = rel_bias[t5_bucket(d) * 12 + col]; }
        if (bid == 0 && wave < DEPTH) { const float* lv = args.in[13] + wave * 128; float a = 0.f, c2 = 0.f;
            if (lane < 32) { a = lv[lane] * lv[32 + lane]; c2 = lv[64 + lane] * lv[96 + lane]; }
            a = wave_sum(a); c2 = wave_sum(c2);
            if (lane == 0) ((float*)(ws + WS_LAM))[wave] = expf(a) - expf(c2) + (0.8f - 0.6f * expf(-0.3f * (float)wave)); }
        LAS float* scr = (LAS float*)lds + wave * (64 * 33);
        constexpr int T_IN = 16 * 93, T_OUT = 16 * 32, T_UP = 16 * 128, T_DOWN = 64 * 32, T_C1 = 32 * 8, T_C2 = 4 * 2, T_LAYER = T_IN + T_OUT + T_UP + T_DOWN + 2 * T_C1 + 2 * T_C2;
        for (int it = gw; it < DEPTH * T_LAYER; it += NGW) {
            const int layer = it / T_LAYER; int r = it % T_LAYER;
            if (r < T_IN) { transpose_item<true>(args.in[1] + (size_t)layer * DM * D_IN, args.in[5] + layer * DM, (bf16_t*)(ws + WS_WIN) + (size_t)layer * LDP * DM, DM, D_IN, r / 93, r % 93, scr, lane); continue; } r -= T_IN;
            if (r < T_OUT) { transpose_item<false>(args.in[2] + (size_t)layer * DM * DM, nullptr, (bf16_t*)(ws + WS_WOUT) + (size_t)layer * DM * DM, DM, DM, r / 32, r % 32, scr, lane); continue; } r -= T_OUT;
            if (r < T_UP) { transpose_item<false>(args.in[3] + (size_t)layer * DM * DFF, args.in[6] + layer * DM, (bf16_t*)(ws + WS_WUP) + (size_t)layer * DFF * DM, DM, DFF, r / 128, r % 128, scr, lane); continue; } r -= T_UP;
            if (r < T_DOWN) { transpose_item<false>(args.in[4] + (size_t)layer * DFF * DM, nullptr, (bf16_t*)(ws + WS_WDOWN) + (size_t)layer * DM * DFF, DFF, DM, r / 32, r % 32, scr, lane); continue; } r -= T_DOWN;
            if (r < 2 * T_C1) { const int kv = r / T_C1; r %= T_C1; transpose_item<false>(args.in[kv ? 11 : 9] + (size_t)layer * 2048 * 256, nullptr, (bf16_t*)(ws + WS_CW1) + (size_t)(layer * 2 + kv) * 256 * 2048, 2048, 256, r / 8, r % 8, scr, lane); continue; } r -= 2 * T_C1;
            { const int kv = r / T_C2; r %= T_C2; transpose_item<false>(args.in[kv ? 12 : 10] + (size_t)layer * 256 * 64, nullptr, (bf16_t*)(ws + WS_CW2) + (size_t)(layer * 2 + kv) * 64 * 256, 256, 64, r / 2, r % 2, scr, lane); }
        }
        for (int m = gw; m < M_TOK; m += NGW) {
            const f32x4* xr = (const f32x4*)(x_in + (size_t)m * DM) + lane; f32x4 v[4]; float s = 0.f;
#pragma unroll
            for (int j = 0; j < 4; ++j) { v[j] = xr[64 * j]; s += (v[j].x * v[j].x + v[j].y * v[j].y) + (v[j].z * v[j].z + v[j].w * v[j].w); }
            s = wave_sum(s); if (lane == 0) rowss[m] = s;
            unsigned long long* o8 = (unsigned long long*)(xb + (size_t)m * DM) + lane;
#pragma unroll
            for (int j = 0; j < 4; ++j) o8[64 * j] = (unsigned long long)pk2(v[j].x, v[j].y) | ((unsigned long long)pk2(v[j].z, v[j].w) << 32);
        }
    }
    if (args.ws == nullptr) grid.sync();
    XBAR();

    for (int layer = 0; layer < DEPTH; ++layer) {
#ifndef NO_P1
        { unsigned char* ws = opq(args.ws); const int G = gridDim.x, bid = blockIdx.x;
          pg8::Gemm g{(const bf16_t*)(ws + WS_XB), (const bf16_t*)(ws + WS_WIN) + (size_t)layer * LDP * DM, M_TOK, LDP, DM}; pg8::StaticOrder S; S.init(M_TOK, LDP, G, bid);
          pg8::EpiScale<0> E{(bf16_t*)(ws + WS_PROJ), LDP, (const float*)(ws + WS_ROWSS) + (size_t)(2 * layer) * M_TOK, 1.0f / DM};
          pg8::gemm_phase<pg8::EpiScale<0>, pg8::StaticOrder, true, true>(lds, g, S, E); }
#endif
        XBAR();
#ifndef NO_P3
        { unsigned char* ws = opq(args.ws); const int tid = opq_tid(), lane = tid & 63, wave = __builtin_amdgcn_readfirstlane(tid >> 6), G = gridDim.x, bid = blockIdx.x, gw = bid * 8 + wave, NGW = G * 8;
          const bf16_t* proj = (const bf16_t*)(ws + WS_PROJ); bf16_t* mixed = (bf16_t*)(ws + WS_MIXED); const float* bt = (const float*)(ws + WS_BIAS);
          const float lambda_init = 0.8f - 0.6f * expf(-0.3f * (float)layer);
          const float lam = ((const float*)(ws + WS_LAM))[layer];
#ifndef NO_NAIVE
          { const int tid_n = opq_tid(), lane_n = tid_n & 63; LAS float* imp = (LAS float*)lds + tid_n;
            for (int wi = gw; wi < 4096; wi += NGW) {
              const int mixer = wi & 3, r = wi >> 2, tb = 31 - (r & 31), bh = r >> 5, b = bh >> 2, h = bh & 3, t0 = tb * 64;
#ifdef NAIVE_SB
              if (mixer == 0) naive_sb(proj, mixed, b, h, t0, lane_n);
#endif
#ifdef NAIVE_MOBA
              if (mixer == 1) naive_moba(proj, (const float*)(ws + WS_KMEAN), bt, mixed, b, h, t0, lane_n);
#endif
#ifdef NAIVE_NSA
              if (mixer == 2) naive_nsa(proj, (const bf16_t*)(ws + WS_KC), (const bf16_t*)(ws + WS_VC), bt, (float*)(ws + WS_NSATMP), mixed, imp, b, h, t0, lane_n);
#endif
#ifdef NAIVE_DIFF
              if (mixer == 3) naive_diff(proj, bt, args.in[14] + layer * 64, lam, 1.0f - lambda_init, mixed, b, h, t0, lane_n);
#endif
            } }
#endif
          __syncthreads();
#define FILL_BIAS_TABLES() do { for (int i_ = tid; i_ < 12 * at::BEXT; i_ += 512) { const int col_ = i_ / at::BEXT, d_ = i_ % at::BEXT - 64; const float bv_ = bt[col_ * 128 + imin(imax(d_, 0), 127)] * at::LOG2E, bfar_ = bt[col_ * 128 + 127] * at::LOG2E; \
              ((LAS float*)(lds + at::L_BIAS))[i_] = bv_; ((LAS float*)(lds + at::L_BIAS))[12 * at::BEXT + i_] = (bv_ - bfar_) / ((col_ < 8 ? 0.125f : 0.17677669529663687f) * at::LOG2E); } } while (0)
          FILL_BIAS_TABLES();
          __syncthreads();
          { unsigned* qhead = (unsigned*)(ws + WS_QCTR) + layer * 64; unsigned* prep_done = (unsigned*)(ws + WS_QCTR) + 128 + layer * 64;
            volatile LAS int* slotp = (volatile LAS int*)(lds + LDS_BYTES - 32);
            bool prep_seen = false;
            for (;;) {
                if (tid == 0) *slotp = (int)atomicAdd(qhead, 1u);
                __syncthreads();
                const int s = *slotp;
                __syncthreads();
                if (s >= 1120) break;
                if (s < 96) {
                    if (s < 64) { const int kv = s >> 5, tile = s & 31;
                        if (tile == 0) ((bf16_t*)(ws + (kv ? WS_VC : WS_KC)))[((tid >> 6) * 128 + 127) * 64 + (tid & 63)] = 0;
                        at::compress_unit(proj, kv ? C_NVC : C_NKC, args.in[kv ? 8 : 7] + layer * 2048, (const bf16_t*)(ws + WS_CW1) + (size_t)(layer * 2 + kv) * 256 * 2048,
                                          (const bf16_t*)(ws + WS_CW2) + (size_t)(layer * 2 + kv) * 64 * 256, (bf16_t*)(ws + (kv ? WS_VC : WS_KC)), lds, tile); }
                    else at::kmean_item(proj, (float*)(ws + WS_KMEAN), (s - 64) * 8 + wave, lane);
                    if (s < 64) FILL_BIAS_TABLES();
                    asm volatile("s_waitcnt vmcnt(0)" ::: "memory");
                    __syncthreads();
                    if (tid == 0) { __builtin_amdgcn_fence(__ATOMIC_RELEASE, "agent"); asm volatile("s_waitcnt vmcnt(0)" ::: "memory"); __hip_atomic_fetch_add(prep_done, 1u, __ATOMIC_RELAXED, __HIP_MEMORY_SCOPE_AGENT); }
                    continue;
                }
                if (s < 352) { const int i = s - 96; at::diff_unit(proj, args.in[14] + layer * 64, lam, 1.0f - lambda_init, mixed, lds, (i & 31) >> 2, i & 3, 7 - (i >> 5)); continue; }
                if (s >= 864) { const int i = s - 864; at::sb_unit(proj, mixed, lds, (i & 31) >> 2, i & 3, 7 - (i >> 5)); continue; }
                if (!prep_seen) {
                    if (tid == 0) { while (__hip_atomic_load(prep_done, __ATOMIC_RELAXED, __HIP_MEMORY_SCOPE_AGENT) < 96u) __builtin_amdgcn_s_sleep(8);
                                    __builtin_amdgcn_fence(__ATOMIC_ACQUIRE, "agent"); asm volatile("s_waitcnt vmcnt(0)" ::: "memory"); }
                    __syncthreads(); prep_seen = true; }
                { const int r = (s - 352) >> 6, w = (s - 352) & 63, i = w & 31;
                  if (w < 32) at::nsa_unit(proj, (const bf16_t*)(ws + WS_KC), (const bf16_t*)(ws + WS_VC), mixed, lds, i & 7, 31 - 4 * r - (i >> 3));
                  else at::moba_unit(proj, (const float*)(ws + WS_KMEAN), mixed, lds, i >> 2, i & 3, 7 - r); }
            } }
          }
#endif
        XBAR();
#ifndef NO_P4
        { unsigned char* ws = opq(args.ws); const int G = gridDim.x, bid = blockIdx.x; float* xres = opq(args.out);
          pg8::Gemm g{(const bf16_t*)(ws + WS_MIXED), (const bf16_t*)(ws + WS_WOUT) + (size_t)layer * DM * DM, M_TOK, DM, DM}; pg8::StaticOrder S; S.init(M_TOK, DM, G, bid);
          pg8::EpiResidual E{layer == 0 ? args.in[0] : (const float*)xres, xres, (bf16_t*)(ws + WS_XB), (float*)(ws + WS_ROWSS) + (size_t)(2 * layer + 1) * M_TOK, DM};
          pg8::gemm_phase<pg8::EpiResidual, pg8::StaticOrder, true, true>(lds, g, S, E); }
#endif
        XBAR();
#ifndef NO_P5
        { unsigned char* ws = opq(args.ws); const int G = gridDim.x, bid = blockIdx.x;
          pg8::Gemm g{(const bf16_t*)(ws + WS_XB), (const bf16_t*)(ws + WS_WUP) + (size_t)layer * DFF * DM, M_TOK, DFF, DM}; pg8::StaticOrder S; S.init(M_TOK, DFF, G, bid);
          pg8::EpiScale<1> E{(bf16_t*)(ws + WS_PROJ), DFF, (const float*)(ws + WS_ROWSS) + (size_t)(2 * layer + 1) * M_TOK, 1.0f / DM};
          pg8::gemm_phase<pg8::EpiScale<1>, pg8::StaticOrder, true, true>(lds, g, S, E); }
#endif
        XBAR();
#ifndef NO_P6
        { unsigned char* ws = opq(args.ws); const int G = gridDim.x, bid = blockIdx.x; float* xres = opq(args.out);
          pg8::Gemm g{(const bf16_t*)(ws + WS_PROJ), (const bf16_t*)(ws + WS_WDOWN) + (size_t)layer * DM * DFF, M_TOK, DM, DFF}; pg8::StaticOrder S; S.init(M_TOK, DM, G, bid);
          pg8::EpiResidual E{xres, xres, (bf16_t*)(ws + WS_XB), (float*)(ws + WS_ROWSS) + (size_t)(2 * layer + 2) * M_TOK, DM};
          pg8::gemm_phase<pg8::EpiResidual, pg8::StaticOrder, true, true>(lds, g, S, E); }
#endif
        XBAR();
    }
    { const int tid = opq_tid(), lane = tid & 63, wave = __builtin_amdgcn_readfirstlane(tid >> 6), gw = blockIdx.x * 8 + wave, NGW = gridDim.x * 8;
      float* xres = opq(args.out); const float* final_norm = args.in[16];
      for (int m = gw; m < M_TOK; m += NGW) {
        f32x4* xr = (f32x4*)(xres + (size_t)m * DM) + lane; const f32x4* gr = (const f32x4*)final_norm + lane; f32x4 v[4]; float s = 0.f;
#pragma unroll
        for (int j = 0; j < 4; ++j) { v[j] = xr[64 * j]; s += (v[j].x * v[j].x + v[j].y * v[j].y) + (v[j].z * v[j].z + v[j].w * v[j].w); }
        const float rs = 1.0f / sqrtf(wave_sum(s) * (1.0f / DM) + 1e-6f);
#pragma unroll
        for (int j = 0; j < 4; ++j) xr[64 * j] = v[j] * rs * gr[64 * j];
      } }
}

extern "C" void kernel_launch(void* const* d_in, const int* in_sizes, int n_in, void* d_out, int out_size, void* d_ws, size_t ws_size, hipStream_t stream) {
    static int grid = 0;
    if (grid == 0) {
        int dev = 0, cus = 0, per_cu = 0;
        if (n_in != 17 || out_size != M_TOK * DM || ws_size < WS_END) { fprintf(stderr, "kernel_launch: unexpected shapes (n_in %d out %d ws %zu)\n", n_in, out_size, ws_size); grid = -1; return; }
        (void)hipGetDevice(&dev); (void)hipDeviceGetAttribute(&cus, hipDeviceAttributeMultiprocessorCount, dev);
        if (hipFuncSetAttribute((const void*)hybrid_fwd, hipFuncAttributeMaxDynamicSharedMemorySize, LDS_BYTES) != hipSuccess) { fprintf(stderr, "kernel_launch: hipFuncSetAttribute failed\n"); grid = -1; return; }
        if (hipOccupancyMaxActiveBlocksPerMultiprocessor(&per_cu, (const void*)hybrid_fwd, 512, LDS_BYTES) != hipSuccess || per_cu < 1) { fprintf(stderr, "kernel_launch: occupancy query gave %d\n", per_cu); grid = -1; return; }
        grid = cus * per_cu;
    }
    if (grid < 0) return;
    if (hipMemsetAsync((char*)d_ws + WS_BAR, 0, 16384, stream) != hipSuccess) { fprintf(stderr, "kernel_launch: hipMemsetAsync failed\n"); return; }
    Args a{};
    for (int i = 0; i < 17; ++i) a.in[i] = (const float*)d_in[i];
    a.out = (float*)d_out; a.ws = (unsigned char*)d_ws;
    void* kargs[] = {&a};
    hipError_t e = hipLaunchCooperativeKernel((const void*)hybrid_fwd, dim3(grid), dim3(512), kargs, LDS_BYTES, stream);
    if (e != hipSuccess) fprintf(stderr, "cooperative launch failed: %s (grid %d)\n", hipGetErrorString(e), grid);
}
```

```cpp
#include <hip/hip_runtime.h>
#include <hip/hip_cooperative_groups.h>
#include <cstdio>
#include <cstdint>
namespace cg = cooperative_groups;

namespace pg8 {
#define PG8_LAS __attribute__((address_space(3)))
typedef unsigned short bf16_t;
typedef short bf16x8 __attribute__((ext_vector_type(8)));
typedef float f32x4 __attribute__((ext_vector_type(4)));
typedef unsigned u32x4 __attribute__((ext_vector_type(4)));
constexpr int BM = 256, BK = 64, HALF = 128, HTB = HALF * BK * 2  , STAGE_BYTES = 8 * HTB, NXCD = 8, WGM = 8;

__host__ __device__ __forceinline__ int lds_byte(int r, int c) { const int st = (r >> 4) * 2 + (c >> 5), rr = r & 15, cc = c & 31, ob = rr * 64 + cc * 2; return st * 1024 + (ob ^ (((ob >> 9) & 1) << 5)); }
__host__ __device__ __forceinline__ void stage_rc(int b, int& R, int& C) { const int st = b / 1024, sb = b % 1024, swz = sb ^ (((sb >> 9) & 1) << 5); R = (st >> 1) * 16 + swz / 64; C = (st & 1) * 32 + (swz % 64) / 2; }
__host__ __device__ __forceinline__ int perm32(int rho) { const int n = rho >> 4, i = rho & 15; return 8 * (i >> 2) + 4 * n + (i & 3); }

struct Unit { int pm, pn; };
struct Gemm { const bf16_t* A; const bf16_t* Bt; int M, N, K; };

struct StaticOrder {
    int nM, nN, nwg, G, c;
    __host__ __device__ void init(int M, int N, int G_, int c_) { nM = M / BM; nN = N / BM; nwg = nM * nN; G = G_; c = c_; }
    __host__ __device__ bool next(int i, Unit& u) const {
        const long L = (long)i * G + c; if (L >= nwg) return false;
        int wgid = (int)L; { const int q = nwg / NXCD, r = nwg % NXCD, xcd = wgid % NXCD, off = wgid / NXCD; wgid = (xcd < r ? xcd * (q + 1) : r * (q + 1) + (xcd - r) * q) + off; }
        const int nig = WGM * nN, gid = wgid / nig, fm = gid * WGM, gsz = (nM - fm) < WGM ? (nM - fm) : WGM;
        u.pm = fm + ((wgid % nig) % gsz); u.pn = (wgid % nig) / gsz; return true;
    }
    __device__ __forceinline__ void a_ready(const Unit&) const {}
    __device__ __forceinline__ void done(const Unit&) const {}
};


__device__ __forceinline__ unsigned cvt_pk_bf16(float lo, float hi) { unsigned r; asm volatile("v_cvt_pk_bf16_f32 %0, %1, %2" : "=v"(r) : "v"(lo), "v"(hi)); return r; }
constexpr float NORM_EPS = 1e-6f;
template <int ACT> struct EpiScale {
    static constexpr bool PERM = true, AFTER_DRAIN = false;
    bf16_t* O; int ldc; const float* rowss; float inv_d;
    __device__ __forceinline__ void operator()(const f32x4 (&acc)[2][2][4][2], const Unit& u, int wr, int wc, int fr, int fq) const {
        const int row0 = u.pm * BM + wr * 64 + fr, col0 = u.pn * BM + wc * 32 + 8 * fq;
#pragma unroll
        for (int ai = 0; ai < 2; ++ai)
#pragma unroll
            for (int m = 0; m < 4; ++m) { const int row = row0 + ai * HALF + m * 16; const float rs = 1.0f / sqrtf(rowss[row] * inv_d + NORM_EPS);
                bf16_t* rowp = O + (size_t)row * ldc + col0;
#pragma unroll
                for (int bj = 0; bj < 2; ++bj) { f32x4 v0 = acc[ai][bj][m][0] * rs, v1 = acc[ai][bj][m][1] * rs;
                    if (ACT == 1) {
#pragma unroll
                        for (int e = 0; e < 4; ++e) { const float a = fmaxf(v0[e], 0.f), b = fmaxf(v1[e], 0.f); v0[e] = a * a; v1[e] = b * b; } }
                    u32x4 w; w.x = cvt_pk_bf16(v0[0], v0[1]); w.y = cvt_pk_bf16(v0[2], v0[3]); w.z = cvt_pk_bf16(v1[0], v1[1]); w.w = cvt_pk_bf16(v1[2], v1[3]);
                    *(u32x4*)(rowp + bj * HALF) = w; } }
    }
};
struct EpiResidual {
    static constexpr bool PERM = true, AFTER_DRAIN = false;
    const float* xin; float* xout; bf16_t* xb; float* rowss_out; int ldc;
    __device__ __forceinline__ void operator()(const f32x4 (&acc)[2][2][4][2], const Unit& u, int wr, int wc, int fr, int fq) const {
        const int row0 = u.pm * BM + wr * 64 + fr, col0 = u.pn * BM + wc * 32 + 8 * fq;
#pragma unroll
        for (int ai = 0; ai < 2; ++ai)
#pragma unroll
            for (int m = 0; m < 4; ++m) { const int row = row0 + ai * HALF + m * 16; const size_t off = (size_t)row * ldc + col0; float ss = 0.f;
#pragma unroll
                for (int bj = 0; bj < 2; ++bj) { const f32x4 r0 = *(const f32x4*)(xin + off + bj * HALF), r1 = *(const f32x4*)(xin + off + bj * HALF + 4);
                    const f32x4 v0 = r0 + acc[ai][bj][m][0], v1 = r1 + acc[ai][bj][m][1];
                    *(f32x4*)(xout + off + bj * HALF) = v0; *(f32x4*)(xout + off + bj * HALF + 4) = v1;
                    u32x4 w; w.x = cvt_pk_bf16(v0[0], v0[1]); w.y = cvt_pk_bf16(v0[2], v0[3]); w.z = cvt_pk_bf16(v1[0], v1[1]); w.w = cvt_pk_bf16(v1[2], v1[3]);
                    *(u32x4*)(xb + off + bj * HALF) = w;
                    ss += (v0[0] * v0[0] + v0[1] * v0[1]) + (v0[2] * v0[2] + v0[3] * v0[3]) + (v1[0] * v1[0] + v1[1] * v1[1]) + (v1[2] * v1[2] + v1[3] * v1[3]); }
                ss += __shfl_xor(ss, 16); ss += __shfl_xor(ss, 32);
                if (fq == 0) atomicAdd(rowss_out + row, ss); }
    }
};

template <class Epi, class Sched, bool ALIGN_EPI = false, bool SP2 = false>
__device__ __forceinline__ void gemm_phase(PG8_LAS unsigned char* lds, const Gemm g, const Sched& S, const Epi& E) {
    int tid_o = threadIdx.x; asm volatile("" : "+v"(tid_o));
    const int tid = tid_o, wid = __builtin_amdgcn_readfirstlane(tid >> 6), lane = tid & 63, wr = wid >> 2, wc = wid & 3, fr = lane & 15, fq = lane >> 4;
    const int K = g.K, nt = K / BK;
    unsigned voffA[2], voffB[2];
#pragma unroll
    for (int i = 0; i < 2; ++i) { int R, C; stage_rc(tid * 16 + i * 8192, R, C); const int Rb = Epi::PERM ? ((R & ~31) + perm32(R & 31)) : R;
        voffA[i] = (unsigned)(R * K + C) * 2u; voffB[i] = (unsigned)(Rb * K + C) * 2u; }
    const size_t kstep = (size_t)(BK * 2);
    const size_t hstep = (size_t)HALF * K * 2;
    const size_t tstep = 2 * hstep;
    const unsigned ldsw = (unsigned)wid * 1024u;
    const int aoff = lds_byte(wr * 64 + fr, fq * 8), boff = lds_byte(wc * 32 + fr, fq * 8);
#define PG8_SA(b, h) (((b) * 2 + (h)) * HTB)
#define PG8_SB(b, h) ((4 + (b) * 2 + (h)) * HTB)
#define PG8_STAGE(bufoff, gbase, voff) do { _Pragma("unroll") for (int _i = 0; _i < 2; ++_i) \
        __builtin_amdgcn_global_load_lds((const unsigned*)((const char*)(gbase) + (voff)[_i]), (PG8_LAS unsigned*)(lds + (bufoff) + ldsw + _i * 8192), 16, 0, 0); } while (0)
#define PG8_LDA(dst, b, h) do { _Pragma("unroll") for (int m = 0; m < 4; ++m) _Pragma("unroll") for (int k = 0; k < 2; ++k) dst[m][k] = *(const PG8_LAS bf16x8*)(lds + PG8_SA(b, h) + aoff + m * 2048 + k * 1024); } while (0)
#define PG8_LDB(dst, b, h) do { _Pragma("unroll") for (int n = 0; n < 2; ++n) _Pragma("unroll") for (int k = 0; k < 2; ++k) dst[n][k] = *(const PG8_LAS bf16x8*)(lds + PG8_SB(b, h) + boff + n * 2048 + k * 1024); } while (0)
#define PG8_MMA(ai, bj, At, Bt) do { __builtin_amdgcn_s_setprio(1); _Pragma("unroll") for (int m = 0; m < 4; ++m) _Pragma("unroll") for (int n = 0; n < 2; ++n) _Pragma("unroll") for (int k = 0; k < 2; ++k) \
        acc[ai][bj][m][n] = __builtin_amdgcn_mfma_f32_16x16x32_bf16(Bt[n][k], At[m][k], acc[ai][bj][m][n], 0, 0, 0); __builtin_amdgcn_s_setprio(0); } while (0)
#define PG8_WAIT_V(n) asm volatile("s_waitcnt vmcnt(" #n ")" ::: "memory")
#define PG8_WAIT_L(n) asm volatile("s_waitcnt lgkmcnt(" #n ")" ::: "memory")
#define PG8_BAR __builtin_amdgcn_s_barrier()
#define PG8_SCHED __builtin_amdgcn_sched_barrier(0)
    Unit cur, nxt; int ui = 0;
    if (!S.next(0, cur)) return;
    f32x4 acc[2][2][4][2];
#pragma unroll
    for (int a = 0; a < 2; ++a)
#pragma unroll
        for (int b = 0; b < 2; ++b)
#pragma unroll
            for (int m = 0; m < 4; ++m)
#pragma unroll
                for (int n = 0; n < 2; ++n) acc[a][b][m][n] = (f32x4){0.f, 0.f, 0.f, 0.f};
    bf16x8 At[4][2], B0[2][2], B1[2][2];
    const char* cA = (const char*)g.A + (size_t)cur.pm * tstep; const char* cB = (const char*)g.Bt + (size_t)cur.pn * tstep;
    S.a_ready(cur);
    if constexpr (SP2) {
        PG8_STAGE(PG8_SB(0, 0), cB, voffB); PG8_STAGE(PG8_SB(0, 1), cB + hstep, voffB); PG8_STAGE(PG8_SA(0, 0), cA, voffA); PG8_STAGE(PG8_SA(0, 1), cA + hstep, voffA);
        if (wr == 1) PG8_BAR;
        PG8_WAIT_V(2); PG8_BAR;
        PG8_STAGE(PG8_SB(1, 0), cB + kstep, voffB); PG8_STAGE(PG8_SA(1, 0), cA + kstep, voffA); PG8_STAGE(PG8_SB(1, 1), cB + hstep + kstep, voffB);
        PG8_WAIT_V(6); PG8_BAR;
    } else {
        PG8_STAGE(PG8_SB(0, 0), cB, voffB); PG8_STAGE(PG8_SA(0, 0), cA, voffA); PG8_STAGE(PG8_SB(0, 1), cB + hstep, voffB); PG8_STAGE(PG8_SA(0, 1), cA + hstep, voffA);
        if (wr == 1) PG8_BAR;
        PG8_WAIT_V(4); PG8_BAR;
        PG8_STAGE(PG8_SB(1, 0), cB + kstep, voffB); PG8_STAGE(PG8_SA(1, 0), cA + kstep, voffA); PG8_STAGE(PG8_SB(1, 1), cB + hstep + kstep, voffB);
        PG8_WAIT_V(6); PG8_BAR;
    }
    for (;;) {
        const bool has_next = S.next(ui + 1, nxt);
        const char* nA = has_next ? (const char*)g.A + (size_t)nxt.pm * tstep : cA; const char* nB = has_next ? (const char*)g.Bt + (size_t)nxt.pn * tstep : cB;
        for (int t = 0; t < nt; t += 2) {
            const bool last = (t == nt - 2);
            const char* a1 = cA + (size_t)(t + 1) * kstep;
            const char* a2 = last ? nA : cA + (size_t)(t + 2) * kstep; const char* b2 = last ? nB : cB + (size_t)(t + 2) * kstep;
            const char* a3 = a2 + kstep; const char* b3 = b2 + kstep;
            if (last && has_next) S.a_ready(nxt);
            if constexpr (SP2) {
            PG8_LDB(B0, 0, 0); PG8_LDB(B1, 0, 1); PG8_SCHED; PG8_LDA(At, 0, 0); PG8_STAGE(PG8_SA(1, 1), a1 + hstep, voffA);
            PG8_WAIT_V(8); PG8_WAIT_L(0); PG8_BAR; PG8_MMA(0, 0, At, B0); PG8_MMA(0, 1, At, B1); PG8_BAR; PG8_SCHED;
            PG8_LDA(At, 0, 1); PG8_STAGE(PG8_SB(0, 0), b2, voffB); PG8_STAGE(PG8_SB(0, 1), b2 + hstep, voffB); PG8_STAGE(PG8_SA(0, 0), a2, voffA);
            PG8_WAIT_V(8); PG8_WAIT_L(0); PG8_BAR; PG8_MMA(1, 0, At, B0); PG8_MMA(1, 1, At, B1); PG8_BAR; PG8_SCHED;
            PG8_LDB(B0, 1, 0); PG8_LDB(B1, 1, 1); PG8_SCHED; PG8_LDA(At, 1, 0); PG8_STAGE(PG8_SA(0, 1), a2 + hstep, voffA);
            PG8_WAIT_V(8); PG8_WAIT_L(0); PG8_BAR; PG8_MMA(0, 0, At, B0); PG8_MMA(0, 1, At, B1); PG8_BAR; PG8_SCHED;
            PG8_LDA(At, 1, 1); PG8_STAGE(PG8_SB(1, 0), b3, voffB); PG8_STAGE(PG8_SB(1, 1), b3 + hstep, voffB); PG8_STAGE(PG8_SA(1, 0), a3, voffA);
            PG8_WAIT_V(8); PG8_WAIT_L(0); PG8_BAR; PG8_MMA(1, 0, At, B0); PG8_MMA(1, 1, At, B1); PG8_BAR; PG8_SCHED;
            } else {
            PG8_LDB(B0, 0, 0); PG8_SCHED; PG8_LDA(At, 0, 0); PG8_STAGE(PG8_SA(1, 1), a1 + hstep, voffA);
            PG8_WAIT_L(8); PG8_BAR; PG8_WAIT_L(0); PG8_MMA(0, 0, At, B0); PG8_BAR; PG8_SCHED;
            PG8_LDB(B1, 0, 1); PG8_STAGE(PG8_SB(0, 0), b2, voffB);
            PG8_BAR; PG8_WAIT_L(0); PG8_MMA(0, 1, At, B1); PG8_BAR;
            PG8_LDA(At, 0, 1); PG8_STAGE(PG8_SA(0, 0), a2, voffA);
            PG8_BAR; PG8_WAIT_L(0); PG8_MMA(1, 0, At, B0); PG8_BAR; PG8_SCHED;
            PG8_STAGE(PG8_SB(0, 1), b2 + hstep, voffB);
            PG8_WAIT_V(6); PG8_BAR; PG8_MMA(1, 1, At, B1); PG8_BAR;
            PG8_LDB(B0, 1, 0); PG8_SCHED; PG8_LDA(At, 1, 0); PG8_STAGE(PG8_SA(0, 1), a2 + hstep, voffA);
            PG8_WAIT_L(8); PG8_BAR; PG8_WAIT_L(0); PG8_MMA(0, 0, At, B0); PG8_BAR; PG8_SCHED;
            PG8_LDB(B1, 1, 1); PG8_STAGE(PG8_SB(1, 0), b3, voffB);
            PG8_BAR; PG8_WAIT_L(0); PG8_MMA(0, 1, At, B1); PG8_BAR;
            PG8_LDA(At, 1, 1); PG8_STAGE(PG8_SA(1, 0), a3, voffA);
            PG8_BAR; PG8_WAIT_L(0); PG8_MMA(1, 0, At, B0); PG8_BAR; PG8_SCHED;
            PG8_STAGE(PG8_SB(1, 1), b3 + hstep, voffB);
            PG8_WAIT_V(6); PG8_BAR; PG8_MMA(1, 1, At, B1); PG8_BAR;
            }
        }
        if constexpr (ALIGN_EPI) { if (wr == 0) PG8_BAR; }
        if constexpr (!Epi::AFTER_DRAIN) { E(acc, cur, wr, wc, fr, fq); S.done(cur); }
        if (!has_next) break;
#pragma unroll
        for (int a = 0; a < 2; ++a)
#pragma unroll
            for (int b = 0; b < 2; ++b)
#pragma unroll
                for (int m = 0; m < 4; ++m)
#pragma unroll
                    for (int n = 0; n < 2; ++n) acc[a][b][m][n] = (f32x4){0.f, 0.f, 0.f, 0.f};
        cur = nxt; cA = nA; cB = nB; ++ui;
        if constexpr (ALIGN_EPI) { if (wr == 1) PG8_BAR; }
    }
    PG8_WAIT_V(0);
    if constexpr (!ALIGN_EPI) { if (wr == 0) PG8_BAR; }
    PG8_BAR;
    if constexpr (Epi::AFTER_DRAIN) { E.fused(acc, cur, wr, wc, fr, fq, lds, wid, lane); S.done(cur); }
#undef PG8_SA
#undef PG8_SB
#undef PG8_STAGE
#undef PG8_LDA
#undef PG8_LDB
#undef PG8_MMA
#undef PG8_WAIT_V
#undef PG8_WAIT_L
#undef PG8_BAR
#undef PG8_SCHED
}
}

#define LAS __attribute__((address_space(3)))
typedef unsigned short bf16_t;
typedef unsigned u32x4 __attribute__((ext_vector_type(4)));
typedef float f32x4 __attribute__((ext_vector_type(4)));
constexpr int BATCH = 8, SEQ = 2048, DM = 1024, DEPTH = 2, HD = 64, DFF = 4096, M_TOK = BATCH * SEQ;
constexpr int D_IN = 2956, LDP = 3072;
constexpr int C_SBQ = 0, C_SBK = 256, C_SBV = 512, C_MBQ = 768, C_MBK = 1024, C_MBV = 1280, C_NSQ = 1536, C_NKC = 1792, C_NVC = 1856, C_NKS = 1920, C_NVS = 1984,
              C_NKW = 2048, C_NVW = 2112, C_DFQ = 2176, C_DFK = 2432, C_DFV = 2688, C_NSG = 2944;
constexpr int N_CMP = 127;
constexpr float NEG_BIG = -1e30f, TINY = 1e-30f;
constexpr size_t MiB = 1u << 20;
constexpr size_t WS_ROWSS = 1 * MiB;
constexpr size_t WS_BIAS = 1 * MiB + 512 * 1024;
constexpr size_t WS_ORDER = WS_BIAS + 48 * 1024;
constexpr size_t WS_QCTR = 14336;
constexpr size_t WS_LAM = WS_BIAS + 32 * 1024;
constexpr size_t WS_KMEAN = WS_BIAS + 64 * 1024;
constexpr size_t WS_KC = 2 * MiB, WS_VC = 2 * MiB + 128 * 1024;
constexpr size_t WS_CW1 = 3 * MiB, WS_CW2 = 7 * MiB;
constexpr size_t WS_WIN = 8 * MiB, WS_WOUT = 20 * MiB, WS_WUP = 24 * MiB, WS_WDOWN = 40 * MiB;
constexpr size_t WS_PROJ = 56 * MiB;
constexpr size_t WS_NSATMP = WS_PROJ + 96 * MiB;
constexpr size_t WS_MIXED = 184 * MiB, WS_XB = 216 * MiB, WS_END = 248 * MiB;
constexpr int LDS_BYTES = 147456;

struct Args { const float* in[17]; float* out; unsigned char* ws; };

__device__ __forceinline__ float bflo(unsigned u) { return __uint_as_float(u << 16); }
__device__ __forceinline__ float bfhi(unsigned u) { return __uint_as_float(u & 0xffff0000u); }
__device__ __forceinline__ unsigned f2bf(float f) { unsigned u = __float_as_uint(f); return (u + 0x7fffu + ((u >> 16) & 1u)) >> 16; }
__device__ __forceinline__ unsigned pk2(float lo, float hi) { return f2bf(lo) | (f2bf(hi) << 16); }
__device__ __forceinline__ float wave_sum(float v) {
#pragma unroll
    for (int o = 1; o < 64; o <<= 1) v += __shfl_xor(v, o);
    return v;
}
__device__ __forceinline__ int t5_bucket(int n) {
    if (n < 16) return n;
    const int large = 16 + (int)(logf((float)n * (1.0f / 16.0f)) / 2.0794415416798357f * 16.0f);
    return large < 31 ? large : 31;
}

constexpr size_t WS_BAR = 0;
#define XB_TMO      128
#define XB_XCNT(j)  (256  + 64 * (j))
#define XB_XSUB(j)  (1280 + 64 * (j))
#define XB_XGEN(j)  (2304 + 64 * (j))
#define XB_TOP      3328
#define XB_TOPGEN   3392
#define XCD_BAR_WORDS 3456
#define XB_SPIN_CAP (1u << 18)

__device__ __forceinline__ unsigned xb_ld(unsigned* p)              { return __hip_atomic_load(p, __ATOMIC_RELAXED, __HIP_MEMORY_SCOPE_AGENT); }
__device__ __forceinline__ unsigned xb_add(unsigned* p, unsigned v) { return __hip_atomic_fetch_add(p, v, __ATOMIC_RELAXED, __HIP_MEMORY_SCOPE_AGENT); }
__device__ __forceinline__ unsigned xb_xcc_id() { return (unsigned)__builtin_amdgcn_s_getreg((3 << 11) | 20) & 0xFu; }
#define XB_SPIN(cond, bar) do { unsigned _sp = 0; while (cond) { __builtin_amdgcn_s_sleep(1); \
    if ((++_sp & 255u) == 0u) { if (xb_ld(&(bar)[XB_TMO])) break; if (_sp > XB_SPIN_CAP) { atomicAdd(&(bar)[XB_TMO], 1u); break; } } } } while (0)

struct XcdBarrier {
    unsigned* bar; unsigned x;
    volatile LAS unsigned* st;
};

__device__ __forceinline__ XcdBarrier xcd_barrier_post(unsigned* bar, volatile LAS unsigned* st) {
    XcdBarrier b; b.bar = bar; b.x = xb_xcc_id(); b.st = st;
    if (threadIdx.x == 0) (void)xb_add(&bar[XB_XCNT(b.x)], 1u);
    return b;
}
__device__ __forceinline__ void xcd_barrier_complete(unsigned* bar, unsigned x, unsigned& nloc, unsigned& nx) {
    const unsigned G = gridDim.x * gridDim.y * gridDim.z;
    unsigned sum, cnt, mine, sp = 0u;
    for (;;) {
        sum = 0u; cnt = 0u; mine = 0u;
#pragma unroll
        for (unsigned j = 0; j < 16; ++j) { const unsigned c = xb_ld(&bar[XB_XCNT(j)]); sum += c; cnt += (c > 0u) ? 1u : 0u; mine = (j == x) ? c : mine; }
        if (sum == G) break;
        __builtin_amdgcn_s_sleep(1);
        if ((++sp & 255u) == 0u) { if (xb_ld(&bar[XB_TMO])) break; if (sp > XB_SPIN_CAP) { atomicAdd(&bar[XB_TMO], 1u); break; } }
    }
    nloc = mine > 0u ? mine : 1u; nx = cnt > 0u ? cnt : 1u;
}

__device__ __forceinline__ void xcd_barrier(const XcdBarrier& b) {
    asm volatile("s_waitcnt vmcnt(0)" ::: "memory");
    __syncthreads();
    if (threadIdx.x == 0) {
        unsigned* bar = b.bar;
        __builtin_amdgcn_s_waitcnt(0);
        unsigned nloc = b.st[0], nx = b.st[1];
        if (nloc == 0u) { xcd_barrier_complete(bar, b.x, nloc, nx); b.st[0] = nloc; b.st[1] = nx; }
        const unsigned old = xb_add(&bar[XB_XSUB(b.x)], 1u);
        const unsigned gen = old / nloc;
        if (old + 1u == (gen + 1u) * nloc) {
            __builtin_amdgcn_fence(__ATOMIC_RELEASE, "agent");
            asm volatile("s_waitcnt vmcnt(0)" ::: "memory");
            const unsigned og = xb_add(&bar[XB_TOP], 1u);
            const unsigned tg = og / nx;
            if (og + 1u == (tg + 1u) * nx) xb_add(&bar[XB_TOPGEN], 1u);
            else XB_SPIN(xb_ld(&bar[XB_TOPGEN]) == tg, bar);
            __builtin_amdgcn_fence(__ATOMIC_ACQUIRE, "agent");
            xb_add(&bar[XB_XGEN(b.x)], 1u);
            asm volatile("s_waitcnt vmcnt(0)" ::: "memory");
        } else {
            XB_SPIN(xb_ld(&bar[XB_XGEN(b.x)]) == gen, bar);
            __builtin_amdgcn_fence(__ATOMIC_ACQUIRE, "agent");
            asm volatile("s_waitcnt vmcnt(0)" ::: "memory");
        }
    }
    __syncthreads();
}

__device__ __forceinline__ float unit_cost(int id) { const int type = id >> 8, idx = id & 255;
    if (type == 0) return 5.6f * (float)((idx >> 5) + 1) + 1.0f;
    if (type == 1) { const int own = idx >> 3; return 5.0f + (float)(own + 1) + (float)(own + 1 < 9 ? own + 1 : 9); }
    if (type == 2) return 4.0f * (float)((idx >> 5) + 1) + 1.5f;
    return 9.0f; }
__device__ __forceinline__ int win_dest(int n) { return n < 2176 ? n : (n < 2188 ? 2944 + (n - 2176) : n - 12); }
template <bool MAP> __device__ __forceinline__ void transpose_item(const float* W, const float* g, bf16_t* WT, int K, int N, int kb, int nb, LAS float* scr, int lane) {
    const int k0 = kb * 64, n0 = nb * 32, n4 = (lane & 7) * 4, kq = lane >> 3; const bool inb = n0 + n4 < N;
    f32x4 v[8];
#pragma unroll
    for (int i = 0; i < 8; ++i) v[i] = inb ? *(const f32x4*)(W + (size_t)(k0 + kq + 8 * i) * N + n0 + n4) : (f32x4){0.f, 0.f, 0.f, 0.f};
#pragma unroll
    for (int i = 0; i < 8; ++i) { const int kk = kq + 8 * i; const float gs = g ? g[k0 + kk] : 1.0f; LAS float* d = scr + kk * 33 + n4;
        d[0] = v[i][0] * gs; d[1] = v[i][1] * gs; d[2] = v[i][2] * gs; d[3] = v[i][3] * gs; }
    asm volatile("s_waitcnt lgkmcnt(0)" ::: "memory");
    const int c = lane & 7;
#pragma unroll
    for (int j = 0; j < 4; ++j) { const int n = (lane >> 3) + 8 * j; const LAS float* s = scr + (8 * c) * 33 + n;
        u32x4 o; o.x = pk2(s[0], s[33]); o.y = pk2(s[2 * 33], s[3 * 33]); o.z = pk2(s[4 * 33], s[5 * 33]); o.w = pk2(s[6 * 33], s[7 * 33]);
        if (n0 + n < N) { const int dest = MAP ? win_dest(n0 + n) : (n0 + n); *(u32x4*)(WT + (size_t)dest * K + k0 + 8 * c) = o; } }
    asm volatile("s_waitcnt lgkmcnt(0)" ::: "memory");
}

template <int NC> __device__ __forceinline__ float dotq(const float* q, const bf16_t* row) {
    const uint4* p = (const uint4*)row; float a = 0.f;
#pragma unroll
    for (int c = 0; c < NC; ++c) { const uint4 w = p[c];
        a = fmaf(q[8 * c + 0], bflo(w.x), a); a = fmaf(q[8 * c + 1], bfhi(w.x), a); a = fmaf(q[8 * c + 2], bflo(w.y), a); a = fmaf(q[8 * c + 3], bfhi(w.y), a);
        a = fmaf(q[8 * c + 4], bflo(w.z), a); a = fmaf(q[8 * c + 5], bfhi(w.z), a); a = fmaf(q[8 * c + 6], bflo(w.w), a); a = fmaf(q[8 * c + 7], bfhi(w.w), a); }
    return a;
}
__device__ __forceinline__ void axpy64(float* o, float p, const bf16_t* row) {
    const uint4* v = (const uint4*)row;
#pragma unroll
    for (int c = 0; c < 8; ++c) { const uint4 w = v[c];
        o[8 * c + 0] = fmaf(p, bflo(w.x), o[8 * c + 0]); o[8 * c + 1] = fmaf(p, bfhi(w.x), o[8 * c + 1]); o[8 * c + 2] = fmaf(p, bflo(w.y), o[8 * c + 2]); o[8 * c + 3] = fmaf(p, bfhi(w.y), o[8 * c + 3]);
        o[8 * c + 4] = fmaf(p, bflo(w.z), o[8 * c + 4]); o[8 * c + 5] = fmaf(p, bfhi(w.z), o[8 * c + 5]); o[8 * c + 6] = fmaf(p, bflo(w.w), o[8 * c + 6]); o[8 * c + 7] = fmaf(p, bfhi(w.w), o[8 * c + 7]); }
}
__device__ __forceinline__ void loadq64(float* q, const bf16_t* row) {
    const uint4* p = (const uint4*)row;
#pragma unroll
    for (int c = 0; c < 8; ++c) { const uint4 w = p[c]; q[8 * c + 0] = bflo(w.x); q[8 * c + 1] = bfhi(w.x); q[8 * c + 2] = bflo(w.y); q[8 * c + 3] = bfhi(w.y);
        q[8 * c + 4] = bflo(w.z); q[8 * c + 5] = bfhi(w.z); q[8 * c + 6] = bflo(w.w); q[8 * c + 7] = bfhi(w.w); }
}
__device__ __forceinline__ void store64_bf16(bf16_t* dst, const float* o, float sc) {
#pragma unroll
    for (int c = 0; c < 8; ++c) { u32x4 w; w.x = pk2(o[8 * c] * sc, o[8 * c + 1] * sc); w.y = pk2(o[8 * c + 2] * sc, o[8 * c + 3] * sc); w.z = pk2(o[8 * c + 4] * sc, o[8 * c + 5] * sc); w.w = pk2(o[8 * c + 6] * sc, o[8 * c + 7] * sc);
        *(u32x4*)(dst + 8 * c) = w; }
}
__device__ __forceinline__ int opq_tid() { int t = threadIdx.x; asm volatile("" : "+v"(t)); return t; }
template <class T> __device__ __forceinline__ T* opq(T* p) { asm volatile("" : "+s"(p)); return p; }
__device__ __forceinline__ float gelu_tanh(float x) { const float u = 0.7978845608028654f * (x + 0.044715f * x * x * x); return 0.5f * x * (1.0f + tanhf(u)); }
__device__ __forceinline__ int imin(int a, int b) { return a < b ? a : b; }
__device__ __forceinline__ int imax(int a, int b) { return a > b ? a : b; }

__device__ __forceinline__ void naive_sb(const bf16_t* proj, bf16_t* mixed, int b, int h, int t0, int lane) {
    const int t = t0 + lane; const size_t row = (size_t)b * SEQ + t;
    float q[64], o[64];
    loadq64(q, proj + row * LDP + C_SBQ + h * 64);
#pragma unroll
    for (int i = 0; i < 64; ++i) o[i] = 0.f;
    float R = 0.f;
    const bf16_t* kb = proj + (size_t)b * SEQ * LDP + C_SBK + h * 64; const bf16_t* vb = proj + (size_t)b * SEQ * LDP + C_SBV + h * 64;
    for (int s = t0 + 62; s >= 0; --s) {
        const bool act = s < t;
        const float z = dotq<8>(q, kb + (size_t)s * LDP) * 0.125f;
        const float sp = fmaxf(z, 0.f) + log1pf(expf(-fabsf(z)));
        const float a = act ? expf((z - sp) + R) : 0.f;
        if (act) R -= sp;
        axpy64(o, a, vb + (size_t)s * LDP);
        if (__all(R < -104.f)) break;
    }
    store64_bf16(mixed + row * DM + 0 + h * 64, o, 1.f);
}

__device__ __forceinline__ void naive_moba(const bf16_t* proj, const float* kmean, const float* bt, bf16_t* mixed, int b, int h, int t0, int lane) {
    const int t = t0 + lane; const size_t row = (size_t)b * SEQ + t; const int own = t0 >> 8;
    float q[64], o[64];
    loadq64(q, proj + row * LDP + C_MBQ + h * 64);
    unsigned sel = 0u;
    { float g[8];
#pragma unroll
      for (int n = 0; n < 8; ++n) { const float* km = kmean + ((size_t)(b * 4 + h) * 8 + n) * 64; float a = 0.f;
#pragma unroll
          for (int d = 0; d < 64; ++d) a = fmaf(q[d], km[d], a);
          g[n] = a; }
      for (int r = 0; r < 3; ++r) { int best = -1; float bv = -3.0e38f;
#pragma unroll
          for (int n = 0; n < 8; ++n) if (n < own && !((sel >> n) & 1u) && g[n] > bv) { bv = g[n]; best = n; }
          if (best >= 0) sel |= 1u << best; } }
    const bf16_t* kb = proj + (size_t)b * SEQ * LDP + C_MBK + h * 64; const bf16_t* vb = proj + (size_t)b * SEQ * LDP + C_MBV + h * 64;
    const float* btab = bt + (0 + h) * 128;
    float m = NEG_BIG;
    for (int n = 0; n <= own; ++n) {
        const bool mine = (n == own) || ((sel >> n) & 1u);
        if (!__any(mine)) continue;
        const int s1 = (n == own) ? t0 + 63 : n * 256 + 255;
        for (int s = n * 256; s <= s1; ++s) { const bool v = mine && s <= t;
            const float sc = dotq<8>(q, kb + (size_t)s * LDP) * 0.125f + btab[imin(imax(t - s, 0), 127)];
            if (v) m = fmaxf(m, sc); } }
#pragma unroll
    for (int i = 0; i < 64; ++i) o[i] = 0.f;
    float l = 0.f;
    for (int n = 0; n <= own; ++n) {
        const bool mine = (n == own) || ((sel >> n) & 1u);
        if (!__any(mine)) continue;
        const int s1 = (n == own) ? t0 + 63 : n * 256 + 255;
        for (int s = n * 256; s <= s1; ++s) { const bool v = mine && s <= t;
            const float sc = dotq<8>(q, kb + (size_t)s * LDP) * 0.125f + btab[imin(imax(t - s, 0), 127)];
            const float e = v ? expf(sc - m) : 0.f; l += e;
            axpy64(o, e, vb + (size_t)s * LDP); } }
    store64_bf16(mixed + row * DM + 256 + h * 64, o, 1.0f / fmaxf(l, TINY));
}

__device__ __forceinline__ void naive_diff(const bf16_t* proj, const float* bt, const float* subln, float lam, float post, bf16_t* mixed, int b, int h, int t0, int lane) {
    const int t = t0 + lane; const size_t row = (size_t)b * SEQ + t;
    float q[64], o[64];
    loadq64(q, proj + row * LDP + C_DFQ + h * 64);
    const bf16_t* kb = proj + (size_t)b * SEQ * LDP + C_DFK + h * 64; const bf16_t* vb = proj + (size_t)b * SEQ * LDP + C_DFV + h * 64;
    const float* btab = bt + (8 + h) * 128; const float scale = 0.17677669529663687f;
    float m1 = NEG_BIG, m2 = NEG_BIG;
    for (int s = 0; s <= t0 + 63; ++s) { const bool v = s <= t; const float bia = btab[imin(imax(t - s, 0), 127)];
        const float s1 = dotq<4>(q, kb + (size_t)s * LDP) * scale + bia, s2 = dotq<4>(q + 32, kb + (size_t)s * LDP + 32) * scale + bia;
        if (v) { m1 = fmaxf(m1, s1); m2 = fmaxf(m2, s2); } }
    float l1 = 0.f, l2 = 0.f;
    for (int s = 0; s <= t0 + 63; ++s) { const bool v = s <= t; const float bia = btab[imin(imax(t - s, 0), 127)];
        const float s1 = dotq<4>(q, kb + (size_t)s * LDP) * scale + bia, s2 = dotq<4>(q + 32, kb + (size_t)s * LDP + 32) * scale + bia;
        if (v) { l1 += expf(s1 - m1); l2 += expf(s2 - m2); } }
    const float r1 = 1.0f / fmaxf(l1, TINY), r2 = lam / fmaxf(l2, TINY);
#pragma unroll
    for (int i = 0; i < 64; ++i) o[i] = 0.f;
    for (int s = 0; s <= t0 + 63; ++s) { const bool v = s <= t; const float bia = btab[imin(imax(t - s, 0), 127)];
        const float s1 = dotq<4>(q, kb + (size_t)s * LDP) * scale + bia, s2 = dotq<4>(q + 32, kb + (size_t)s * LDP + 32) * scale + bia;
        const float w = v ? (expf(s1 - m1) * r1 - expf(s2 - m2) * r2) : 0.f;
        axpy64(o, w, vb + (size_t)s * LDP); }
    float ss = 0.f;
#pragma unroll
    for (int i = 0; i < 64; ++i) ss = fmaf(o[i], o[i], ss);
    const float rs = post / sqrtf(ss * (1.0f / 64.0f) + 1e-6f);
#pragma unroll
    for (int i = 0; i < 64; ++i) o[i] *= subln[i];
    store64_bf16(mixed + row * DM + 768 + h * 64, o, rs);
}

__device__ __forceinline__ void axpy32(float* o, float p, const bf16_t* row) {
    const uint4* v = (const uint4*)row;
#pragma unroll
    for (int c = 0; c < 4; ++c) { const uint4 w = v[c];
        o[8 * c + 0] = fmaf(p, bflo(w.x), o[8 * c + 0]); o[8 * c + 1] = fmaf(p, bfhi(w.x), o[8 * c + 1]); o[8 * c + 2] = fmaf(p, bflo(w.y), o[8 * c + 2]); o[8 * c + 3] = fmaf(p, bfhi(w.y), o[8 * c + 3]);
        o[8 * c + 4] = fmaf(p, bflo(w.z), o[8 * c + 4]); o[8 * c + 5] = fmaf(p, bfhi(w.z), o[8 * c + 5]); o[8 * c + 6] = fmaf(p, bflo(w.w), o[8 * c + 6]); o[8 * c + 7] = fmaf(p, bfhi(w.w), o[8 * c + 7]); }
}
__device__ __forceinline__ void naive_nsa(const bf16_t* proj, const bf16_t* kc, const bf16_t* vc, const float* bt, float* tmp, bf16_t* mixed, LAS float* imp, int b, int h, int t0, int lane) {
    const int t = t0 + lane; const size_t row = (size_t)b * SEQ + t; const int own = t0 >> 6;
    const int ncv = t >= 31 ? imin(((t - 31) >> 4) + 1, N_CMP) : 0;
    const int ncw = imin(((t0 + 63 - 31) >> 4) + 1, N_CMP);
    const bf16_t* kcb = kc + (size_t)b * 128 * 64; const bf16_t* vcb = vc + (size_t)b * 128 * 64;
    float* trow = tmp + (row * 4 + h) * 64;
    float q[64];
#pragma unroll
    for (int j = 0; j < 32; ++j) imp[j * 512] = 0.f;
    float mh = NEG_BIG, rlh = 0.f;
#pragma unroll 1
    for (int hh = 0; hh < 4; ++hh) {
        loadq64(q, proj + row * LDP + C_NSQ + hh * 64);
        const float* btab = bt + (4 + hh) * 128;
        float m = NEG_BIG;
#pragma unroll 1
        for (int c = 0; c < ncw; ++c) { const float sc = dotq<8>(q, kcb + c * 64) * 0.125f + btab[imin(imax(t - (16 * c + 31), 0), 127)]; if (c < ncv) m = fmaxf(m, sc); }
        float l = 0.f;
#pragma unroll 1
        for (int c = 0; c < ncw; ++c) { const float sc = dotq<8>(q, kcb + c * 64) * 0.125f + btab[imin(imax(t - (16 * c + 31), 0), 127)]; if (c < ncv) l += expf(sc - m); }
        const float rl = 1.0f / fmaxf(l, TINY);
        if (hh == h) { mh = m; rlh = rl; }
#pragma unroll 1
        for (int c = 0; c < ncw; ++c) { const float sc = dotq<8>(q, kcb + c * 64) * 0.125f + btab[imin(imax(t - (16 * c + 31), 0), 127)];
            const float p = (c < ncv) ? expf(sc - m) * rl : 0.f;
            const int j = c >> 2;
            if ((c & 3) == 3) { imp[j * 512] += 0.5f * p; if (j + 1 < 32) imp[(j + 1) * 512] += 0.5f * p; } else imp[j * 512] += p; }
    }
    unsigned sel = 1u << own;
    for (int r = 0; r < 3; ++r) { int best = -1; float bv = -3.0e38f;
        for (int j = 0; j < own; ++j) { const float v = imp[j * 512]; if (!((sel >> j) & 1u) && v > bv) { bv = v; best = j; } }
        if (best >= 0) sel |= 1u << best; }
    loadq64(q, proj + row * LDP + C_NSQ + h * 64);
    const float* btab = bt + (4 + h) * 128;
    const bf16_t* grow = proj + row * LDP + C_NSG;
    const float g0 = 1.0f / (1.0f + expf(-__uint_as_float((unsigned)grow[0 * 4 + h] << 16))), g1 = 1.0f / (1.0f + expf(-__uint_as_float((unsigned)grow[1 * 4 + h] << 16))),
                g2 = 1.0f / (1.0f + expf(-__uint_as_float((unsigned)grow[2 * 4 + h] << 16)));
    const bf16_t* ksb = proj + (size_t)b * SEQ * LDP + C_NKS; const bf16_t* vsb = proj + (size_t)b * SEQ * LDP + C_NVS;
    const bf16_t* kwb = proj + (size_t)b * SEQ * LDP + C_NKW; const bf16_t* vwb = proj + (size_t)b * SEQ * LDP + C_NVW;
    float ms = NEG_BIG, ls = 0.f, mw = NEG_BIG, lw = 0.f;
#pragma unroll 1
    for (int j = 0; j <= own; ++j) { const bool mine = (sel >> j) & 1u; if (!__any(mine)) continue;
#pragma unroll 1
        for (int s = j * 64; s < j * 64 + 64; ++s) { const float sc = dotq<8>(q, ksb + (size_t)s * LDP) * 0.125f + btab[imin(imax(t - s, 0), 127)]; if (mine && s <= t) ms = fmaxf(ms, sc); } }
#pragma unroll 1
    for (int j = 0; j <= own; ++j) { const bool mine = (sel >> j) & 1u; if (!__any(mine)) continue;
#pragma unroll 1
        for (int s = j * 64; s < j * 64 + 64; ++s) { const float sc = dotq<8>(q, ksb + (size_t)s * LDP) * 0.125f + btab[imin(imax(t - s, 0), 127)]; if (mine && s <= t) ls += expf(sc - ms); } }
    const int sw0 = imax(t0 - 511, 0);
#pragma unroll 1
    for (int s = sw0; s <= t0 + 63; ++s) { const float sc = dotq<8>(q, kwb + (size_t)s * LDP) * 0.125f + btab[imin(imax(t - s, 0), 127)]; if (s <= t && t - s < 512) mw = fmaxf(mw, sc); }
#pragma unroll 1
    for (int s = sw0; s <= t0 + 63; ++s) { const float sc = dotq<8>(q, kwb + (size_t)s * LDP) * 0.125f + btab[imin(imax(t - s, 0), 127)]; if (s <= t && t - s < 512) lw += expf(sc - mw); }
    const float rs = g1 / fmaxf(ls, TINY), rw = g2 / fmaxf(lw, TINY), rc = g0 * rlh;
#pragma unroll 1
    for (int half = 0; half < 2; ++half) {
        float o[32];
#pragma unroll
        for (int i = 0; i < 32; ++i) o[i] = 0.f;
#pragma unroll 1
        for (int c = 0; c < ncw; ++c) { const float sc = dotq<8>(q, kcb + c * 64) * 0.125f + btab[imin(imax(t - (16 * c + 31), 0), 127)];
            const float p = (c < ncv) ? expf(sc - mh) * rc : 0.f; axpy32(o, p, vcb + c * 64 + half * 32); }
#pragma unroll 1
        for (int j = 0; j <= own; ++j) { const bool mine = (sel >> j) & 1u; if (!__any(mine)) continue;
#pragma unroll 1
            for (int s = j * 64; s < j * 64 + 64; ++s) { const float sc = dotq<8>(q, ksb + (size_t)s * LDP) * 0.125f + btab[imin(imax(t - s, 0), 127)];
                const float e = (mine && s <= t) ? expf(sc - ms) * rs : 0.f; axpy32(o, e, vsb + (size_t)s * LDP + half * 32); } }
#pragma unroll 1
        for (int s = sw0; s <= t0 + 63; ++s) { const float sc = dotq<8>(q, kwb + (size_t)s * LDP) * 0.125f + btab[imin(imax(t - s, 0), 127)];
            const float e = (s <= t && t - s < 512) ? expf(sc - mw) * rw : 0.f; axpy32(o, e, vwb + (size_t)s * LDP + half * 32); }
        bf16_t* dst = mixed + row * DM + 512 + h * 64 + half * 32;
#pragma unroll
        for (int c = 0; c < 4; ++c) { u32x4 w; w.x = pk2(o[8 * c], o[8 * c + 1]); w.y = pk2(o[8 * c + 2], o[8 * c + 3]); w.z = pk2(o[8 * c + 4], o[8 * c + 5]); w.w = pk2(o[8 * c + 6], o[8 * c + 7]);
            *(u32x4*)(dst + 8 * c) = w; }
    }
    (void)trow;
}

namespace at {
typedef short bf16x8 __attribute__((ext_vector_type(8)));
typedef short s16x4 __attribute__((ext_vector_type(4)));
typedef float f32x16 __attribute__((ext_vector_type(16)));
constexpr int NSLOT = 5, SLOT_B = 16384, SLOT_V = 8192;
constexpr int L_BIAS = NSLOT * SLOT_B;
constexpr int BEXT = 288;
constexpr int L_MISC = L_BIAS + 2 * 12 * BEXT * 4;
constexpr float LOG2E = 1.4426950408889634f;
#define MFMA32(a, b, c) __builtin_amdgcn_mfma_f32_32x32x16_bf16((a), (b), (c), 0, 0, 0)
__device__ __forceinline__ int crow(int i, int hi) { return (i & 3) + 8 * (i >> 2) + 4 * hi; }
__device__ __forceinline__ s16x4 vtr(const LAS unsigned char* p) { typedef short v4i16_t __attribute__((ext_vector_type(4))); return __builtin_bit_cast(s16x4, __builtin_amdgcn_ds_read_tr16_b64_v4i16((LAS v4i16_t*)p)); }
__device__ __forceinline__ unsigned cvtpk(float lo, float hi) { typedef float f2 __attribute__((ext_vector_type(2))); typedef __bf16 b2 __attribute__((ext_vector_type(2))); f2 v = {lo, hi}; b2 b = __builtin_convertvector(v, b2); return __builtin_bit_cast(unsigned, b); }
__device__ __forceinline__ bf16x8 pack8(const f32x16& p, int s) { u32x4 w; w.x = cvtpk(p[8 * s], p[8 * s + 1]); w.y = cvtpk(p[8 * s + 2], p[8 * s + 3]); w.z = cvtpk(p[8 * s + 4], p[8 * s + 5]); w.w = cvtpk(p[8 * s + 6], p[8 * s + 7]); return __builtin_bit_cast(bf16x8, w); }
__device__ __forceinline__ float xhalf(float v) { return __shfl_xor(v, 32); }
__device__ __forceinline__ void glds16(const void* gsrc, unsigned lds_dst) { unsigned keep;
    asm volatile("s_mov_b32 %0, m0\n\ts_mov_b32 m0, %2\n\ts_nop 0\n\tglobal_load_lds_dwordx4 %1, off\n\ts_mov_b32 m0, %0" : "=&s"(keep) : "v"(gsrc), "s"(lds_dst) : "memory"); }
template <int PITCH = LDP> __device__ __forceinline__ void dma_tile(const bf16_t* kbase, const bf16_t* vbase, int s0, LAS unsigned char* lds, int slot, int wave, int lane) {
    const unsigned dst = (unsigned)(uintptr_t)lds + (unsigned)(slot * SLOT_B + wave * 1024);
    glds16(kbase + (size_t)(s0 + lane) * PITCH + wave * 8, (unsigned)__builtin_amdgcn_readfirstlane((int)dst));
    glds16(vbase + (size_t)(s0 + 16 * (wave & 3) + (lane >> 2)) * PITCH + (wave >> 2) * 32 + (lane & 3) * 8, (unsigned)__builtin_amdgcn_readfirstlane((int)(dst + SLOT_V)));
}
#define WAIT_BAR(N) asm volatile("s_waitcnt vmcnt(" #N ") lgkmcnt(0)\n\ts_barrier" ::: "memory")
#define END_STEP3(i, n) do { if ((i) + 3 < (n)) WAIT_BAR(4); else if ((i) + 2 < (n)) WAIT_BAR(2); else WAIT_BAR(0); } while (0)
#define END_STEP(i, n) do { if ((i) + 4 < (n)) WAIT_BAR(4); else if ((i) + 3 < (n)) WAIT_BAR(2); else WAIT_BAR(0); } while (0)
template <int D0, int ND> __device__ __forceinline__ void qk(f32x16& p0, f32x16& p1, const LAS unsigned char* kb, const bf16x8 (&q)[4], int lane) {
    const LAS unsigned char* a = kb + (lane >> 5) * 1024 + (lane & 31) * 16;
    constexpr int NB = ND > 2 ? 2 : ND;
#pragma unroll
    for (int d1 = 0; d1 < ND; d1 += NB) {
        bf16x8 kf[2 * NB];
#pragma unroll
        for (int d = 0; d < NB; ++d) { kf[2 * d] = *(const LAS bf16x8*)(a + (D0 + d1 + d) * 2048); kf[2 * d + 1] = *(const LAS bf16x8*)(a + (D0 + d1 + d) * 2048 + 512); }
        __builtin_amdgcn_sched_barrier(0);
#pragma unroll
        for (int d = 0; d < NB; ++d) { p0 = MFMA32(kf[2 * d], q[D0 + d1 + d], p0); p1 = MFMA32(kf[2 * d + 1], q[D0 + d1 + d], p1); }
    }
}
__device__ __forceinline__ void pv(f32x16 (&o)[2], const LAS unsigned char* vb, const bf16x8 (&pk)[4], int lane) {
    const int i16 = lane & 15, hi = lane >> 5;
    const LAS unsigned char* base = vb + (4 * hi + (i16 >> 2)) * 64 + ((lane >> 4) & 1) * 32 + (i16 & 3) * 8;
#pragma unroll
    for (int half = 0; half < 2; ++half) {
        s16x4 lo[4], hh[4];
#pragma unroll
        for (int s2 = 0; s2 < 2; ++s2)
#pragma unroll
            for (int db = 0; db < 2; ++db) { const int s = 2 * half + s2; lo[2 * s2 + db] = vtr(base + db * 4096 + s * 1024); hh[2 * s2 + db] = vtr(base + db * 4096 + s * 1024 + 512); }
        __builtin_amdgcn_sched_barrier(0);
#pragma unroll
        for (int s2 = 0; s2 < 2; ++s2)
#pragma unroll
            for (int db = 0; db < 2; ++db) { const s16x4 l = lo[2 * s2 + db], h = hh[2 * s2 + db];
                const bf16x8 vf = {l[0], l[1], l[2], l[3], h[0], h[1], h[2], h[3]};
                o[db] = MFMA32(vf, pk[2 * half + s2], o[db]); }
    }
}
__device__ __forceinline__ void osm(f32x16& p0, f32x16& p1, float& m, float& l, f32x16 (&o)[2]) {
    float mx = fmaxf(p0[0], p1[0]);
#pragma unroll
    for (int i = 1; i < 16; ++i) mx = fmaxf(mx, fmaxf(p0[i], p1[i]));
    mx = fmaxf(mx, xhalf(mx));
    const float mn = fmaxf(m, mx);
    if (__any(mn > m)) { const float al = __builtin_amdgcn_exp2f(m - mn); l *= al;
#pragma unroll
        for (int i = 0; i < 16; ++i) { o[0][i] *= al; o[1][i] *= al; }
        m = mn; }
    float s = 0.f;
#pragma unroll
    for (int i = 0; i < 16; ++i) { p0[i] = __builtin_amdgcn_exp2f(p0[i] - m); p1[i] = __builtin_amdgcn_exp2f(p1[i] - m); s += p0[i] + p1[i]; }
    l += s;
}
template <bool CAUSAL> __device__ __forceinline__ void bias_mask(f32x16& p0, f32x16& p1, float c2, const LAS float* b2e, int tq, int s0, int hi, bool near, bool diag) {
    if (!near) { const float bc = b2e[64 + 127];
#pragma unroll
        for (int i = 0; i < 16; ++i) { p0[i] = fmaf(p0[i], c2, bc); p1[i] = fmaf(p1[i], c2, bc); }
    } else {
        const int rel = tq - s0 - 4 * hi;
        const LAS float* bp = b2e + (rel + 64 - 63);
#pragma unroll
        for (int i = 0; i < 16; ++i) { const int k0 = (i & 3) + 8 * (i >> 2);
            p0[i] = fmaf(p0[i], c2, bp[63 - k0]); p1[i] = fmaf(p1[i], c2, bp[63 - k0 - 32]); }
        if (CAUSAL && diag) {
#pragma unroll
            for (int i = 0; i < 16; ++i) { const int k0 = (i & 3) + 8 * (i >> 2);
                if (rel < k0) p0[i] = -INFINITY; if (rel < k0 + 32) p1[i] = -INFINITY; } }
    }
}

constexpr float SM_THR = 8.0f;
__device__ __forceinline__ float max32(const f32x16& p0, const f32x16& p1) {
    float a = fmaxf(fmaxf(p0[0], p0[1]), p1[0]), b = fmaxf(fmaxf(p0[2], p0[3]), p1[1]); a = fmaxf(fmaxf(a, p1[2]), p1[3]);
#pragma unroll
    for (int r = 4; r < 16; r += 4) { a = fmaxf(fmaxf(a, p0[r]), p0[r + 1]); b = fmaxf(fmaxf(b, p0[r + 2]), p0[r + 3]); a = fmaxf(fmaxf(a, p1[r]), p1[r + 1]); b = fmaxf(fmaxf(b, p1[r + 2]), p1[r + 3]); }
    return fmaxf(a, b);
}
template <bool LANEMASK, bool LOWER> __device__ __forceinline__ void soft(f32x16& p0, f32x16& p1, float c2, const LAS float* b2e, int rel, bool near, bool diag, bool mine, bool low, int r1,
                                                                          float& m, float& l, f32x16 (&o)[2]) {
    const float bc = b2e[64 + 127];
    if (near) {
        const LAS float* bp = b2e + 12 * BEXT + (rel + 64 - 63);
#pragma unroll
        for (int i = 0; i < 16; ++i) { const int k0 = (i & 3) + 8 * (i >> 2); p0[i] += bp[63 - k0]; p1[i] += bp[63 - k0 - 32]; }
        if (diag) {
#pragma unroll
            for (int i = 0; i < 16; ++i) { const int k0 = (i & 3) + 8 * (i >> 2); if (rel < k0) p0[i] = -INFINITY; if (rel < k0 + 32) p1[i] = -INFINITY; } }
    }
    if (LOWER && low) {
#pragma unroll
        for (int i = 0; i < 16; ++i) { const int k0 = (i & 3) + 8 * (i >> 2); if (k0 < r1) p0[i] = -INFINITY; if (k0 + 32 < r1) p1[i] = -INFINITY; } }
    float tm = max32(p0, p1); tm = fmaxf(tm, xhalf(tm)); tm = fmaf(tm, c2, bc);
    if (LANEMASK && !mine) tm = -INFINITY;
    const float mn = tm > m + SM_THR ? tm : m, al = __builtin_amdgcn_exp2f(m - mn);
    m = mn; l *= al;
#pragma unroll
    for (int i = 0; i < 16; ++i) { o[0][i] *= al; o[1][i] *= al; }
    float off = bc - m; if (LANEMASK && !mine) off = -INFINITY;
    float s = 0.f;
#pragma unroll
    for (int i = 0; i < 16; ++i) { p0[i] = __builtin_amdgcn_exp2f(fmaf(p0[i], c2, off)); p1[i] = __builtin_amdgcn_exp2f(fmaf(p1[i], c2, off)); s += p0[i] + p1[i]; }
    l += s;
}
template <int D0, int ND> __device__ __forceinline__ void qk_issue(f32x16& p0, f32x16& p1, const LAS unsigned char* kb, const bf16x8 (&q)[4], int lane) {
#pragma unroll
    for (int i = 0; i < 16; ++i) { p0[i] = 0.f; p1[i] = 0.f; }
    qk<D0, ND>(p0, p1, kb, q, lane);
}
#define SOFT_PV(LM, LW, P0, P1, VB, O, M, L, NEAR, DIAG, MINE, LOW, R1) do { soft<LM, LW>(P0, P1, c2, b2, tq - s0_ - 4 * hi, NEAR, DIAG, MINE, LOW, R1, M, L, O); \
    bf16x8 pk_[4] = {pack8(P0, 0), pack8(P0, 1), pack8(P1, 0), pack8(P1, 1)}; pv(O, VB, pk_, lane); } while (0)

template <int D0, int ND, bool LM> __device__ __forceinline__ void causal_pass(const bf16_t* kbase, const bf16_t* vbase, LAS unsigned char* lds, const bf16x8 (&q)[4], float c2, const LAS float* b2,
        int tq, int tq0, int hi, int lane, int wave, int nt, int own, unsigned sel, float& m, float& l, f32x16 (&o)[2]) {
#pragma unroll
    for (int k = 0; k < 4; ++k) if (k < nt) dma_tile(kbase, vbase, 64 * k, lds, k, wave, lane);
    END_STEP(-1, nt);
    f32x16 sc0, sc1, sn0, sn1;
    qk_issue<D0, ND>(sc0, sc1, lds, q, lane);
    int sl = 0, sl4 = 4;
#define MB_STEP(C0, C1, N0, N1, j) do { \
        const LAS unsigned char* vb = lds + sl * SLOT_B + SLOT_V; const int sn = sl == NSLOT - 1 ? 0 : sl + 1; \
        if ((j) + 4 < nt) dma_tile(kbase, vbase, 64 * ((j) + 4), lds, sl4, wave, lane); \
        qk_issue<D0, ND>(N0, N1, lds + ((j) + 1 < nt ? sn : sl) * SLOT_B, q, lane); __builtin_amdgcn_sched_barrier(0);     \
        { const int s0_ = 64 * (j), nb = (j) >> 2; const bool mine = nb >= own || ((sel >> nb) & 1u); \
          SOFT_PV(LM, false, C0, C1, vb, o, m, l, (tq0 - (s0_ + 63)) < 113, (s0_ + 63) > tq0, mine, false, 0); __builtin_amdgcn_sched_barrier(0); } \
        END_STEP(j, nt); \
        sl = sn; sl4 = sl4 == NSLOT - 1 ? 0 : sl4 + 1; } while (0)
    for (int j = 0; j < nt; j += 2) { MB_STEP(sc0, sc1, sn0, sn1, j); MB_STEP(sn0, sn1, sc0, sc1, j + 1); }
#undef MB_STEP
}

__device__ __forceinline__ void diff_unit(const bf16_t* proj, const float* subln, float lam, float post, bf16_t* mixed, LAS unsigned char* lds, int b, int h, int qb) {
    const int tid = opq_tid(), lane = tid & 63, wave = __builtin_amdgcn_readfirstlane(tid >> 6), hi = lane >> 5;
    const int tq0 = qb * 256 + wave * 32, tq = tq0 + (lane & 31);
    const bf16_t* kbase = proj + (size_t)b * SEQ * LDP + C_DFK + h * 64; const bf16_t* vbase = proj + (size_t)b * SEQ * LDP + C_DFV + h * 64;
    const LAS float* b2 = (const LAS float*)(lds + L_BIAS) + (8 + h) * BEXT;
    bf16x8 q[4];
    { const bf16_t* qrow = proj + ((size_t)b * SEQ + tq) * LDP + C_DFQ + h * 64 + hi * 8;
#pragma unroll
      for (int d0 = 0; d0 < 4; ++d0) q[d0] = *(const bf16x8*)(qrow + d0 * 16); }
    const float c2 = 0.17677669529663687f * LOG2E;
    float m1 = -1e30f, m2 = -1e30f, l1 = 0.f, l2 = 0.f; f32x16 o1[2], o2[2];
#pragma unroll
    for (int i = 0; i < 16; ++i) { o1[0][i] = 0.f; o1[1][i] = 0.f; o2[0][i] = 0.f; o2[1][i] = 0.f; }
    causal_pass<0, 2, false>(kbase, vbase, lds, q, c2, b2, tq, tq0, hi, lane, wave, 4 * (qb + 1), 0, 0u, m1, l1, o1);
    l1 += xhalf(l1);
    { const float r1 = 1.0f / fmaxf(l1, TINY);
#pragma unroll
      for (int i = 0; i < 16; ++i) { o1[0][i] *= r1; o1[1][i] *= r1; } }
    causal_pass<2, 2, false>(kbase, vbase, lds, q, c2, b2, tq, tq0, hi, lane, wave, 4 * (qb + 1), 0, 0u, m2, l2, o2);
    l2 += xhalf(l2);
    const float r1 = 1.0f, r2 = lam / fmaxf(l2, TINY);
    float ss = 0.f;
#pragma unroll
    for (int db = 0; db < 2; ++db)
#pragma unroll
        for (int i = 0; i < 16; ++i) { const float v = o1[db][i] * r1 - o2[db][i] * r2; o1[db][i] = v; ss = fmaf(v, v, ss); }
    ss += xhalf(ss);
    const float rs = post / sqrtf(ss * (1.0f / 64.0f) + 1e-6f);
    bf16_t* orow = mixed + ((size_t)b * SEQ + tq) * DM + 768 + h * 64;
#pragma unroll
    for (int db = 0; db < 2; ++db)
#pragma unroll
        for (int g = 0; g < 4; ++g) { const int d = 32 * db + 8 * g + 4 * hi; const f32x4 gn = *(const f32x4*)(subln + d);
            uint2 w; w.x = pk2(o1[db][4 * g] * rs * gn[0], o1[db][4 * g + 1] * rs * gn[1]); w.y = pk2(o1[db][4 * g + 2] * rs * gn[2], o1[db][4 * g + 3] * rs * gn[3]);
            *(uint2*)(orow + d) = w; }
}

__device__ __forceinline__ void store_ot(bf16_t* orow, const f32x16 (&o)[2], float sc, int hi) {
#pragma unroll
    for (int db = 0; db < 2; ++db)
#pragma unroll
        for (int g = 0; g < 4; ++g) { uint2 w; w.x = pk2(o[db][4 * g] * sc, o[db][4 * g + 1] * sc); w.y = pk2(o[db][4 * g + 2] * sc, o[db][4 * g + 3] * sc);
            *(uint2*)(orow + 32 * db + 8 * g + 4 * hi) = w; }
}

__device__ __forceinline__ void moba_unit(const bf16_t* proj, const float* kmean, bf16_t* mixed, LAS unsigned char* lds, int b, int h, int own) {
    const int tid = opq_tid(), lane = tid & 63, wave = __builtin_amdgcn_readfirstlane(tid >> 6), hi = lane >> 5;
    const int tq0 = own * 256 + wave * 32, tq = tq0 + (lane & 31);
    const bf16_t* kbase = proj + (size_t)b * SEQ * LDP + C_MBK + h * 64; const bf16_t* vbase = proj + (size_t)b * SEQ * LDP + C_MBV + h * 64;
    const LAS float* b2 = (const LAS float*)(lds + L_BIAS) + (0 + h) * BEXT;
    bf16x8 q[4];
    { const bf16_t* qrow = proj + ((size_t)b * SEQ + tq) * LDP + C_MBQ + h * 64 + hi * 8;
#pragma unroll
      for (int d0 = 0; d0 < 4; ++d0) q[d0] = *(const bf16x8*)(qrow + d0 * 16); }
    unsigned sel = 0u;
    { float g[7];
#pragma unroll
      for (int n = 0; n < 7; ++n) { float a = 0.f;
          if (n < own) { const float* km = kmean + ((size_t)(b * 4 + h) * 8 + n) * 64 + hi * 8;
#pragma unroll
              for (int d0 = 0; d0 < 4; ++d0) { const f32x4 k0 = *(const f32x4*)(km + d0 * 16), k1 = *(const f32x4*)(km + d0 * 16 + 4); const u32x4 qw = __builtin_bit_cast(u32x4, q[d0]);
                  a = fmaf(bflo(qw.x), k0[0], a); a = fmaf(bfhi(qw.x), k0[1], a); a = fmaf(bflo(qw.y), k0[2], a); a = fmaf(bfhi(qw.y), k0[3], a);
                  a = fmaf(bflo(qw.z), k1[0], a); a = fmaf(bfhi(qw.z), k1[1], a); a = fmaf(bflo(qw.w), k1[2], a); a = fmaf(bfhi(qw.w), k1[3], a); } }
          g[n] = a + xhalf(a); }
#pragma unroll
      for (int r = 0; r < 3; ++r) { int best = -1; float bv = -3.0e38f;
#pragma unroll
          for (int n = 0; n < 7; ++n) if (n < own && !((sel >> n) & 1u) && g[n] > bv) { bv = g[n]; best = n; }
          if (best >= 0) sel |= 1u << best; } }
    const float c2 = 0.125f * LOG2E;
    float m = -1e30f, l = 0.f; f32x16 o[2];
#pragma unroll
    for (int i = 0; i < 16; ++i) { o[0][i] = 0.f; o[1][i] = 0.f; }
    causal_pass<0, 4, true>(kbase, vbase, lds, q, c2, b2, tq, tq0, hi, lane, wave, 4 * (own + 1), own, sel, m, l, o);
    l += xhalf(l);
    store_ot(mixed + ((size_t)b * SEQ + tq) * DM + 256 + h * 64, o, 1.0f / fmaxf(l, TINY), hi);
}

constexpr int L_IMP = L_MISC, L_WM = L_IMP + 4 * 64 * 33 * 4, L_NSA_END = L_WM + 64;
__device__ __forceinline__ void nsa_unit(const bf16_t* proj, const bf16_t* kc, const bf16_t* vc, bf16_t* mixed, LAS unsigned char* lds, int b, int own) {
    const int tid = opq_tid(), lane = tid & 63, wave = __builtin_amdgcn_readfirstlane(tid >> 6), hi = lane >> 5, hd = wave >> 1, qs = wave & 1;
    const int t0 = own * 64, tq0 = t0 + qs * 32, ql = qs * 32 + (lane & 31), tq = t0 + ql;
    const LAS float* b2 = (const LAS float*)(lds + L_BIAS) + (4 + hd) * BEXT;
    LAS float* IMP = (LAS float*)(lds + L_IMP); LAS unsigned* WM = (LAS unsigned*)(lds + L_WM);
    const size_t rowq = (size_t)b * SEQ + tq;
    bf16x8 q[4];
    { const bf16_t* qrow = proj + rowq * LDP + C_NSQ + hd * 64 + hi * 8;
#pragma unroll
      for (int d0 = 0; d0 < 4; ++d0) q[d0] = *(const bf16x8*)(qrow + d0 * 16); }
    const float c2 = 0.125f * LOG2E;
    f32x16 acc[2];
    {
        const bf16_t* kcb = kc + (size_t)b * 128 * 64; const bf16_t* vcb = vc + (size_t)b * 128 * 64;
        const bool two = (imin(((t0 + 32) >> 4) + 1, N_CMP)) > 64;
        dma_tile<64>(kcb, vcb, 0, lds, 0, wave, lane);
        if (two) dma_tile<64>(kcb, vcb, 64, lds, 1, wave, lane);
        WAIT_BAR(0);
        f32x16 p[4];
#pragma unroll
        for (int e = 0; e < 4; ++e)
#pragma unroll
            for (int i = 0; i < 16; ++i) p[e][i] = 0.f;
        qk<0, 4>(p[0], p[1], lds, q, lane);
        if (two) qk<0, 4>(p[2], p[3], lds + SLOT_B, q, lane);
        float mx = -INFINITY;
#pragma unroll
        for (int e = 0; e < 4; ++e)
#pragma unroll
            for (int i = 0; i < 16; ++i) { const int c = 32 * e + crow(i, hi), dist = tq - 31 - 16 * c;
                const float v = dist >= 0 ? fmaf(p[e][i], c2, b2[64 + imin(imax(dist, 0), 127)]) : -INFINITY; p[e][i] = v; mx = fmaxf(mx, v); }
        mx = fmaxf(mx, xhalf(mx)); const float ms = (mx == -INFINITY) ? 0.f : mx;
        float sum = 0.f;
#pragma unroll
        for (int e = 0; e < 4; ++e)
#pragma unroll
            for (int i = 0; i < 16; ++i) { p[e][i] = __builtin_amdgcn_exp2f(p[e][i] - ms); sum += p[e][i]; }
        sum += xhalf(sum); const float rl = 1.0f / fmaxf(sum, TINY);
#pragma unroll
        for (int e = 0; e < 4; ++e)
#pragma unroll
            for (int i = 0; i < 16; ++i) p[e][i] *= rl;
#pragma unroll
        for (int i = 0; i < 16; ++i) { acc[0][i] = 0.f; acc[1][i] = 0.f; }
        { bf16x8 pk[4] = {pack8(p[0], 0), pack8(p[0], 1), pack8(p[1], 0), pack8(p[1], 1)}; pv(acc, lds + SLOT_V, pk, lane); }
        if (two) { bf16x8 pk[4] = {pack8(p[2], 0), pack8(p[2], 1), pack8(p[3], 0), pack8(p[3], 1)}; pv(acc, lds + SLOT_B + SLOT_V, pk, lane); }
        float part[16], sp[16];
#pragma unroll
        for (int e = 0; e < 16; ++e) { const f32x16& P = p[e >> 2]; const int m4 = e & 3; sp[e] = 0.5f * P[4 * m4 + 3]; part[e] = (P[4 * m4] + P[4 * m4 + 1]) + (P[4 * m4 + 2] + sp[e]); }
        LAS float* irow = IMP + (hd * 64 + ql) * 33 + hi;
        float prev = 0.f;
#pragma unroll
        for (int e = 0; e < 16; ++e) { const float xo = xhalf(sp[e]); const float recv = hi ? xo : prev; prev = xo; irow[2 * e] = part[e] + recv; }
        const float g0 = 1.0f / (1.0f + __expf(-__uint_as_float((unsigned)proj[rowq * LDP + C_NSG + 0 * 4 + hd] << 16)));
#pragma unroll
        for (int i = 0; i < 16; ++i) { acc[0][i] *= g0; acc[1][i] *= g0; }
    }
    __syncthreads();
    unsigned sel = 1u << own;
    { float v1 = -3.0e38f, v2 = -3.0e38f, v3 = -3.0e38f; int i1 = -1, i2 = -1, i3 = -1;
      const LAS float* ir = IMP + ql * 33;
#pragma unroll 1
      for (int j = 0; j < own; ++j) { const float v = ((ir[j] + ir[64 * 33 + j]) + ir[2 * 64 * 33 + j]) + ir[3 * 64 * 33 + j];
          if (v > v1) { v3 = v2; i3 = i2; v2 = v1; i2 = i1; v1 = v; i1 = j; } else if (v > v2) { v3 = v2; i3 = i2; v2 = v; i2 = j; } else if (v > v3) { v3 = v; i3 = j; } }
      if (i1 >= 0) sel |= 1u << i1; if (i2 >= 0) sel |= 1u << i2; if (i3 >= 0) sel |= 1u << i3; }
    unsigned bm;
    { unsigned wm = sel;
#pragma unroll
      for (int o = 1; o < 64; o <<= 1) wm |= (unsigned)__shfl_xor((int)wm, o);
      if (lane == 0) WM[wave] = wm;
      __syncthreads();
      bm = WM[0] | WM[1] | WM[2] | WM[3] | WM[4] | WM[5] | WM[6] | WM[7]; }
#pragma unroll 1
    for (int br = 1; br <= 2; ++br) {
        const bf16_t* kbase = proj + (size_t)b * SEQ * LDP + (br == 1 ? C_NKS : C_NKW); const bf16_t* vbase = proj + (size_t)b * SEQ * LDP + (br == 1 ? C_NVS : C_NVW);
        unsigned rem = br == 1 ? bm : (((own >= 8 ? 0x1ffu << (own - 8) : 0x1ffu >> (8 - own))) & ((2u << own) - 1u));
        float m = -1e30f, l = 0.f; f32x16 o[2];
#pragma unroll
        for (int i = 0; i < 16; ++i) { o[0][i] = 0.f; o[1][i] = 0.f; }
        const int n = __popc(rem); unsigned iss = rem;
#pragma unroll
        for (int k = 0; k < 4; ++k) if (iss) { const int t = __ffs((int)iss) - 1; iss &= iss - 1u; dma_tile(kbase, vbase, 64 * t, lds, k, wave, lane); }
        END_STEP(-1, n);
        f32x16 sc0, sc1, sn0, sn1;
        int jc = __ffs((int)rem) - 1; rem &= rem - 1u;
        qk_issue<0, 4>(sc0, sc1, lds, q, lane);
        int sl = 0, sl4 = 4;
#define NS_STEP(C0, C1, N0, N1, i) do { \
            const LAS unsigned char* vb = lds + sl * SLOT_B + SLOT_V; const int sn = sl == NSLOT - 1 ? 0 : sl + 1; \
            if (iss) { const int t = __ffs((int)iss) - 1; iss &= iss - 1u; dma_tile(kbase, vbase, 64 * t, lds, sl4, wave, lane); } \
            const int jn = rem ? __ffs((int)rem) - 1 : -1; rem &= rem - 1u; \
            qk_issue<0, 4>(N0, N1, lds + (jn >= 0 ? sn : sl) * SLOT_B, q, lane); __builtin_amdgcn_sched_barrier(0); \
            { const int s0_ = 64 * jc; const bool mine = br == 2 || ((sel >> jc) & 1u); \
              SOFT_PV(true, true, C0, C1, vb, o, m, l, (tq0 - (s0_ + 63)) < 113, jc == own, mine, br == 2 && jc == own - 8, ql + 1 - 4 * hi); __builtin_amdgcn_sched_barrier(0); } \
            END_STEP(i, n); \
            jc = jn; sl = sn; sl4 = sl4 == NSLOT - 1 ? 0 : sl4 + 1; } while (0)
        for (int i = 0; i < n; i += 2) { NS_STEP(sc0, sc1, sn0, sn1, i); if (i + 1 < n) NS_STEP(sn0, sn1, sc0, sc1, i + 1); }
#undef NS_STEP
        l += xhalf(l);
        const float g = 1.0f / (1.0f + __expf(-__uint_as_float((unsigned)proj[rowq * LDP + C_NSG + br * 4 + hd] << 16))) / fmaxf(l, TINY);
#pragma unroll
        for (int i = 0; i < 16; ++i) { acc[0][i] = fmaf(o[0][i], g, acc[0][i]); acc[1][i] = fmaf(o[1][i], g, acc[1][i]); }
    }
    store_ot(mixed + rowq * DM + 512 + hd * 64, acc, 1.0f, hi);
}

constexpr int L_DONE = L_MISC;
__device__ __forceinline__ void sb_unit(const bf16_t* proj, bf16_t* mixed, LAS unsigned char* lds, int b, int h, int qb) {
    const int tid = opq_tid(), lane = tid & 63, wave = __builtin_amdgcn_readfirstlane(tid >> 6), hi = lane >> 5;
    const int tq0 = qb * 256 + wave * 32, tq = tq0 + (lane & 31);
    const bf16_t* kbase = proj + (size_t)b * SEQ * LDP + C_SBK + h * 64; const bf16_t* vbase = proj + (size_t)b * SEQ * LDP + C_SBV + h * 64;
    LAS unsigned* DONE = (LAS unsigned*)(lds + L_DONE);
    bf16x8 q[4];
    { const bf16_t* qrow = proj + ((size_t)b * SEQ + tq) * LDP + C_SBQ + h * 64 + hi * 8;
#pragma unroll
      for (int d0 = 0; d0 < 4; ++d0) q[d0] = *(const bf16x8*)(qrow + d0 * 16); }
    float R = 0.f; f32x16 o[2];
#pragma unroll
    for (int i = 0; i < 16; ++i) { o[0][i] = 0.f; o[1][i] = 0.f; }
    const int jtop = 4 * qb + 3, jw = 4 * qb + (wave >> 1);
    bool wdone = false;
    const int nt = jtop + 1;
#pragma unroll
    for (int k = 0; k < 3; ++k) if (k < nt) dma_tile(kbase, vbase, 64 * (jtop - k), lds, k, wave, lane);
    END_STEP3(-1, nt);
    int it = 0;
    for (int j = jtop; j >= 0; --j, ++it) {
        const LAS unsigned char* kb = lds + (it & 3) * SLOT_B; const LAS unsigned char* vb = kb + SLOT_V;
        if (it + 3 < nt) dma_tile(kbase, vbase, 64 * (j - 3), lds, (it + 3) & 3, wave, lane);
        if (j <= jw && !wdone) {
            const int s0 = 64 * j;
            f32x16 p0, p1;
#pragma unroll
            for (int i = 0; i < 16; ++i) { p0[i] = 0.f; p1[i] = 0.f; }
            qk<0, 4>(p0, p1, kb, q, lane);
            const int rel = tq - s0 - 4 * hi;
            f32x16 lk0, lk1;
#pragma unroll
            for (int i = 0; i < 16; ++i) { const int k0 = (i & 3) + 8 * (i >> 2);
                const float z0 = p0[i] * 0.125f, z1 = p1[i] * 0.125f;
                const float sp0 = fmaxf(z0, 0.f) + 0.6931471805599453f * __builtin_amdgcn_logf(1.0f + __builtin_amdgcn_exp2f(-fabsf(z0) * LOG2E));
                const float sp1 = fmaxf(z1, 0.f) + 0.6931471805599453f * __builtin_amdgcn_logf(1.0f + __builtin_amdgcn_exp2f(-fabsf(z1) * LOG2E));
                const bool v0 = k0 < rel, v1 = k0 + 32 < rel;
                lk0[i] = v0 ? -sp0 : 0.f; lk1[i] = v1 ? -sp1 : 0.f;
                p0[i] = v0 ? z0 - sp0 : -INFINITY; p1[i] = v1 ? z1 - sp1 : -INFINITY; }
            float gs[8];
#pragma unroll
            for (int e = 0; e < 8; ++e) { f32x16& L = (e < 4) ? lk0 : lk1; f32x16& P = (e < 4) ? p0 : p1; const int m4 = e & 3;
                const float x0 = L[4 * m4], x1 = L[4 * m4 + 1], x2 = L[4 * m4 + 2], x3 = L[4 * m4 + 3];
                const float w2 = x3, w1 = x3 + x2, w0 = w1 + x1; gs[e] = w0 + x0;
                P[4 * m4] += w0; P[4 * m4 + 1] += w1; P[4 * m4 + 2] += w2; }
            float above = R, tot = 0.f;
#pragma unroll
            for (int e = 7; e >= 0; --e) { f32x16& P = (e < 4) ? p0 : p1; const int m4 = e & 3;
                const float xo = xhalf(gs[e]); const float ab = above + (hi ? 0.f : xo);
                P[4 * m4] += ab; P[4 * m4 + 1] += ab; P[4 * m4 + 2] += ab; P[4 * m4 + 3] += ab;
                above += gs[e] + xo; tot += gs[e] + xo; }
            R += tot;
#pragma unroll
            for (int i = 0; i < 16; ++i) { p0[i] = __builtin_amdgcn_exp2f(p0[i] * LOG2E); p1[i] = __builtin_amdgcn_exp2f(p1[i] * LOG2E); }
            bf16x8 pk[4] = {pack8(p0, 0), pack8(p0, 1), pack8(p1, 0), pack8(p1, 1)}; pv(o, vb, pk, lane);
            wdone = __all(R < -104.f);
        }
        if (lane == 0) DONE[(it & 1) * 8 + wave] = wdone ? 1u : 0u;
        END_STEP3(it, nt);
        const LAS unsigned* dn = DONE + (it & 1) * 8;
        if ((dn[0] & dn[1] & dn[2] & dn[3] & dn[4] & dn[5] & dn[6] & dn[7]) != 0u) break;
    }
    WAIT_BAR(0);
    store_ot(mixed + ((size_t)b * SEQ + tq) * DM + 0 + h * 64, o, 1.0f, hi);
}

constexpr int CA_STR = 4112, CH_STR = 528;
__device__ __forceinline__ void compress_unit(const bf16_t* proj, int col0, const float* pos, const bf16_t* w1t, const bf16_t* w2t, bf16_t* outp, LAS unsigned char* lds, int tile) {
    const int tid = opq_tid(), lane = tid & 63, wave = __builtin_amdgcn_readfirstlane(tid >> 6), hi = lane >> 5;
    {
      const int sr = tid >> 4, r = imin(tile * 32 + sr, 8 * N_CMP - 1), rb = r / N_CMP, rc = r % N_CMP, lq = (tid & 15) >> 2, dq = (tid & 3) * 16;
      const bf16_t* src = proj + ((size_t)rb * SEQ + 16 * rc + lq) * LDP + col0 + dq;
#pragma unroll 2
      for (int ch = 0; ch < 8; ++ch) {
          const u32x4 x0 = *(const u32x4*)(src + (size_t)(4 * ch) * LDP), x1 = *(const u32x4*)(src + (size_t)(4 * ch) * LDP + 8);
          const float* pp = pos + (4 * ch + lq) * 64 + dq; const f32x4 q0 = *(const f32x4*)pp, q1 = *(const f32x4*)(pp + 4), q2 = *(const f32x4*)(pp + 8), q3 = *(const f32x4*)(pp + 12);
          u32x4 y0, y1;
          y0.x = pk2(bflo(x0.x) + q0[0], bfhi(x0.x) + q0[1]); y0.y = pk2(bflo(x0.y) + q0[2], bfhi(x0.y) + q0[3]); y0.z = pk2(bflo(x0.z) + q1[0], bfhi(x0.z) + q1[1]); y0.w = pk2(bflo(x0.w) + q1[2], bfhi(x0.w) + q1[3]);
          y1.x = pk2(bflo(x1.x) + q2[0], bfhi(x1.x) + q2[1]); y1.y = pk2(bflo(x1.y) + q2[2], bfhi(x1.y) + q2[3]); y1.z = pk2(bflo(x1.z) + q3[0], bfhi(x1.z) + q3[1]); y1.w = pk2(bflo(x1.w) + q3[2], bfhi(x1.w) + q3[3]);
          LAS unsigned char* d = lds + sr * CA_STR + ((4 * ch + lq) * 64 + dq) * 2; *(LAS u32x4*)d = y0; *(LAS u32x4*)(d + 16) = y1; } }
    __syncthreads();
    f32x16 acc;
#pragma unroll
    for (int i = 0; i < 16; ++i) acc[i] = 0.f;
    { const LAS unsigned char* ap = lds + (lane & 31) * CA_STR + hi * 16; const bf16_t* bsrc = w1t + (size_t)(wave * 32 + (lane & 31)) * 2048 + hi * 8;
#pragma unroll 16
      for (int ks = 0; ks < 128; ++ks) { const bf16x8 af = *(const LAS bf16x8*)(ap + ks * 32); const bf16x8 bfr = *(const bf16x8*)(bsrc + ks * 16); acc = MFMA32(af, bfr, acc); } }
    __syncthreads();
    { const int n = wave * 32 + (lane & 31);
#pragma unroll
      for (int i = 0; i < 16; ++i) *(LAS bf16_t*)(lds + crow(i, hi) * CH_STR + n * 2) = (bf16_t)f2bf(gelu_tanh(acc[i])); }
    __syncthreads();
    if (wave < 2) {
        f32x16 o2;
#pragma unroll
        for (int i = 0; i < 16; ++i) o2[i] = 0.f;
        const LAS unsigned char* ap = lds + (lane & 31) * CH_STR + hi * 16; const bf16_t* b2p = w2t + (size_t)(wave * 32 + (lane & 31)) * 256 + hi * 8;
#pragma unroll
        for (int ks = 0; ks < 16; ++ks) { const bf16x8 af = *(const LAS bf16x8*)(ap + ks * 32); const bf16x8 bfr = *(const bf16x8*)(b2p + ks * 16); o2 = MFMA32(af, bfr, o2); }
        const int n = wave * 32 + (lane & 31);
#pragma unroll
        for (int i = 0; i < 16; ++i) { const int rr = tile * 32 + crow(i, hi); if (rr < 8 * N_CMP) outp[((size_t)(rr / N_CMP) * 128 + rr % N_CMP) * 64 + n] = (bf16_t)f2bf(o2[i]); }
    }
    __syncthreads();
}
__device__ __forceinline__ void kmean_item(const bf16_t* proj, float* kmean, int item, int lane) {
    const int n = item & 7, bh = item >> 3, b = bh >> 2, h = bh & 3;
    const bf16_t* kb = proj + ((size_t)b * SEQ + n * 256 + (lane >> 3)) * LDP + C_MBK + h * 64 + (lane & 7) * 8;
    float a[8];
#pragma unroll
    for (int i = 0; i < 8; ++i) a[i] = 0.f;
#pragma unroll 8
    for (int i = 0; i < 32; ++i) { const u32x4 w = *(const u32x4*)(kb + (size_t)(8 * i) * LDP);
        a[0] += bflo(w.x); a[1] += bfhi(w.x); a[2] += bflo(w.y); a[3] += bfhi(w.y); a[4] += bflo(w.z); a[5] += bfhi(w.z); a[6] += bflo(w.w); a[7] += bfhi(w.w); }
#pragma unroll
    for (int i = 0; i < 8; ++i) { a[i] += __shfl_xor(a[i], 8); a[i] += __shfl_xor(a[i], 16); a[i] += __shfl_xor(a[i], 32); }
    if (lane < 8) { float* o = kmean + (size_t)item * 64 + lane * 8;
        *(f32x4*)o = (f32x4){a[0], a[1], a[2], a[3]} * (1.0f / 256.0f); *(f32x4*)(o + 4) = (f32x4){a[4], a[5], a[6], a[7]} * (1.0f / 256.0f); }
}
}

__device__ __forceinline__ void prep_kmean(const bf16_t* proj, float* kmean, LAS float* scr, int item, int tid) {
    const int n = item & 7, bh = item >> 3, b = bh >> 2, h = bh & 3, d = tid & 63, part = tid >> 6;
    const bf16_t* kb = proj + ((size_t)b * SEQ + n * 256 + part * 32) * LDP + C_MBK + h * 64 + d;
    float a = 0.f;
    for (int i = 0; i < 32; ++i) a += __uint_as_float((unsigned)kb[(size_t)i * LDP] << 16);
    scr[part * 64 + d] = a;
    __syncthreads();
    if (tid < 64) { float s = 0.f;
#pragma unroll
        for (int p = 0; p < 8; ++p) s += scr[p * 64 + tid];
        kmean[(size_t)item * 64 + tid] = s * (1.0f / 256.0f); }
    __syncthreads();
}
__device__ __forceinline__ void prep_compress_naive(const bf16_t* proj, const float* pos, const float* w1, const float* w2, bf16_t* outp, int col0, LAS float* scr, int b, int c, int tid) {
    LAS float* a = scr;
    LAS float* part = scr + 2048;
    LAS float* hid = scr + 2560;
    for (int i = tid; i < 2048; i += 512) { const int l = i >> 6, d = i & 63;
        a[i] = __uint_as_float((unsigned)proj[((size_t)b * SEQ + 16 * c + l) * LDP + col0 + d] << 16) + pos[i]; }
    __syncthreads();
    { const int j = tid & 255, kh = tid >> 8; float s = 0.f; const float* w = w1 + (size_t)kh * 1024 * 256 + j; const LAS float* ap = a + kh * 1024;
      for (int k = 0; k < 1024; ++k) s = fmaf(ap[k], w[(size_t)k * 256], s);
      part[kh * 256 + j] = s; }
    __syncthreads();
    if (tid < 256) hid[tid] = gelu_tanh(part[tid] + part[256 + tid]);
    __syncthreads();
    if (tid < 64) { float s = 0.f;
        for (int j = 0; j < 256; ++j) s = fmaf(hid[j], w2[j * 64 + tid], s);
        outp[((size_t)b * 128 + c) * 64 + tid] = (bf16_t)f2bf(s); }
    __syncthreads();
}

constexpr int T_IN = 16 * 93, T_OUT = 16 * 32, T_UP = 16 * 128, T_DOWN = 64 * 32, T_C1 = 32 * 8, T_C2 = 4 * 2, T_CMP = 2 * T_C1 + 2 * T_C2;
constexpr int N_CONV_EARLY = T_IN + 2 * T_CMP, N_CONV_LATE = T_IN + 2 * (T_OUT + T_UP + T_DOWN), N_CONV = N_CONV_EARLY + N_CONV_LATE, N_CONV_UNITS = (N_CONV_LATE + 63) / 64;
__device__ __forceinline__ void convert_item(const Args& args, unsigned char* ws, int it, LAS float* scr, int lane) {
    int r = it, layer = 0;
    if (r < T_IN) { transpose_item<true>(args.in[1], args.in[5], (bf16_t*)(ws + WS_WIN), DM, D_IN, r / 93, r % 93, scr, lane); return; } r -= T_IN;
    if (r < 2 * T_CMP) { layer = r / T_CMP; r %= T_CMP;
        if (r < 2 * T_C1) { const int kv = r / T_C1; r %= T_C1; transpose_item<false>(args.in[kv ? 11 : 9] + (size_t)layer * 2048 * 256, nullptr, (bf16_t*)(ws + WS_CW1) + (size_t)(layer * 2 + kv) * 256 * 2048, 2048, 256, r / 8, r % 8, scr, lane); return; } r -= 2 * T_C1;
        { const int kv = r / T_C2; r %= T_C2; transpose_item<false>(args.in[kv ? 12 : 10] + (size_t)layer * 256 * 64, nullptr, (bf16_t*)(ws + WS_CW2) + (size_t)(layer * 2 + kv) * 64 * 256, 256, 64, r / 2, r % 2, scr, lane); return; } }
    r -= 2 * T_CMP;
    if (r >= T_OUT + T_UP + T_DOWN) { r -= T_OUT + T_UP + T_DOWN; layer = 1;
        if (r < T_IN) { transpose_item<true>(args.in[1] + (size_t)DM * D_IN, args.in[5] + DM, (bf16_t*)(ws + WS_WIN) + (size_t)LDP * DM, DM, D_IN, r / 93, r % 93, scr, lane); return; } r -= T_IN; }
    if (r < T_OUT) { transpose_item<false>(args.in[2] + (size_t)layer * DM * DM, nullptr, (bf16_t*)(ws + WS_WOUT) + (size_t)layer * DM * DM, DM, DM, r / 32, r % 32, scr, lane); return; } r -= T_OUT;
    if (r < T_UP) { transpose_item<false>(args.in[3] + (size_t)layer * DM * DFF, args.in[6] + layer * DM, (bf16_t*)(ws + WS_WUP) + (size_t)layer * DFF * DM, DM, DFF, r / 128, r % 128, scr, lane); return; } r -= T_UP;
    transpose_item<false>(args.in[4] + (size_t)layer * DFF * DM, nullptr, (bf16_t*)(ws + WS_WDOWN) + (size_t)layer * DM * DFF, DFF, DM, r / 32, r % 32, scr, lane);
}

__global__ void __launch_bounds__(512, 2) hybrid_fwd(Args args) {
    extern __shared__ __attribute__((aligned(16))) unsigned char lds_raw[];
    cg::grid_group grid = cg::this_grid();
    LAS unsigned char* lds = (LAS unsigned char*)lds_raw;
    volatile LAS unsigned* xb_st = (volatile LAS unsigned*)(lds + LDS_BYTES - 16);
    if (threadIdx.x < 2) xb_st[threadIdx.x] = 0u;
    __syncthreads();
    if (threadIdx.x == 0) (void)xb_add(&((unsigned*)(opq(args.ws) + WS_BAR))[XB_XCNT(xb_xcc_id())], 1u);
#define XBAR() do { XcdBarrier xb_; xb_.bar = (unsigned*)(opq(args.ws) + WS_BAR); xb_.x = xb_xcc_id(); xb_.st = xb_st; xcd_barrier(xb_); } while (0)

    {
        const int tid = opq_tid(), lane = tid & 63, wave = __builtin_amdgcn_readfirstlane(tid >> 6), G = gridDim.x, bid = blockIdx.x, gw = bid * 8 + wave, NGW = G * 8;
        unsigned char* ws = opq(args.ws);
        float* rowss = (float*)(ws + WS_ROWSS); float* bt = (float*)(ws + WS_BIAS); bf16_t* xb = (bf16_t*)(ws + WS_XB);
        const float* x_in = args.in[0]; const float* rel_bias = args.in[15];
        for (int i = bid * 512 + tid; i < 4 * M_TOK; i += G * 512) rowss[M_TOK + i] = 0.f;
        for (int i = bid * 512 + tid; i < 12 * 128; i += G * 512) { const int col = i >> 7, d = i & 127; bt[i] = rel_bias[t5_bucket(d) * 12 + col]; }
        if (bid == 0 && wave < DEPTH) { const float* lv = args.in[13] + wave * 128; float a = 0.f, c2 = 0.f;
            if (lane < 32) { a = lv[lane] * lv[32 + lane]; c2 = lv[64 + lane] * lv[96 + lane]; }
            a = wave_sum(a); c2 = wave_sum(c2);
            if (lane == 0) ((float*)(ws + WS_LAM))[wave] = expf(a) - expf(c2) + (0.8f - 0.6f * expf(-0.3f * (float)wave)); }
        LAS float* scr = (LAS float*)lds + wave * (64 * 33);
        for (int it = gw; it < N_CONV; it += NGW) convert_item(args, ws, it, scr, lane);
        for (int m = gw; m < M_TOK; m += NGW) {
            const f32x4* xr = (const f32x4*)(x_in + (size_t)m * DM) + lane; f32x4 v[4]; float s = 0.f;
#pragma unroll
            for (int j = 0; j < 4; ++j) { v[j] = xr[64 * j]; s += (v[j].x * v[j].x + v[j].y * v[j].y) + (v[j].z * v[j].z + v[j].w * v[j].w); }
            s = wave_sum(s); if (lane == 0) rowss[m] = s;
            unsigned long long* o8 = (unsigned long long*)(xb + (size_t)m * DM) + lane;
#pragma unroll
            for (int j = 0; j < 4; ++j) o8[64 * j] = (unsigned long long)pk2(v[j].x, v[j].y) | ((unsigned long long)pk2(v[j].z, v[j].w) << 32);
        }
    }
    if (args.ws == nullptr) grid.sync();
    XBAR();

    for (int layer = 0; layer < DEPTH; ++layer) {
#ifndef NO_P1
        { unsigned char* ws = opq(args.ws); const int G = gridDim.x, bid = blockIdx.x;
          pg8::Gemm g{(const bf16_t*)(ws + WS_XB), (const bf16_t*)(ws + WS_WIN) + (size_t)layer * LDP * DM, M_TOK, LDP, DM}; pg8::StaticOrder S; S.init(M_TOK, LDP, G, bid);
          pg8::EpiScale<0> E{(bf16_t*)(ws + WS_PROJ), LDP, (const float*)(ws + WS_ROWSS) + (size_t)(2 * layer) * M_TOK, 1.0f / DM};
          pg8::gemm_phase<pg8::EpiScale<0>, pg8::StaticOrder, true, true>(lds, g, S, E); }
#endif
        XBAR();
#ifndef NO_P3
        { unsigned char* ws = opq(args.ws); const int tid = opq_tid(), lane = tid & 63, wave = __builtin_amdgcn_readfirstlane(tid >> 6), G = gridDim.x, bid = blockIdx.x, gw = bid * 8 + wave, NGW = G * 8;
          const bf16_t* proj = (const bf16_t*)(ws + WS_PROJ); bf16_t* mixed = (bf16_t*)(ws + WS_MIXED); const float* bt = (const float*)(ws + WS_BIAS);
          const float lambda_init = 0.8f - 0.6f * expf(-0.3f * (float)layer);
          const float lam = ((const float*)(ws + WS_LAM))[layer];
#ifndef NO_NAIVE
          { const int tid_n = opq_tid(), lane_n = tid_n & 63; LAS float* imp = (LAS float*)lds + tid_n;
            for (int wi = gw; wi < 4096; wi += NGW) {
              const int mixer = wi & 3, r = wi >> 2, tb = 31 - (r & 31), bh = r >> 5, b = bh >> 2, h = bh & 3, t0 = tb * 64;
#ifdef NAIVE_SB
              if (mixer == 0) naive_sb(proj, mixed, b, h, t0, lane_n);
#endif
#ifdef NAIVE_MOBA
              if (mixer == 1) naive_moba(proj, (const float*)(ws + WS_KMEAN), bt, mixed, b, h, t0, lane_n);
#endif
#ifdef NAIVE_NSA
              if (mixer == 2) naive_nsa(proj, (const bf16_t*)(ws + WS_KC), (const bf16_t*)(ws + WS_VC), bt, (float*)(ws + WS_NSATMP), mixed, imp, b, h, t0, lane_n);
#endif
#ifdef NAIVE_DIFF
              if (mixer == 3) naive_diff(proj, bt, args.in[14] + layer * 64, lam, 1.0f - lambda_init, mixed, b, h, t0, lane_n);
#endif
            } }
#endif
          __syncthreads();
#define FILL_BIAS_TABLES() do { for (int i_ = tid; i_ < 12 * at::BEXT; i_ += 512) { const int col_ = i_ / at::BEXT, d_ = i_ % at::BEXT - 64; const float bv_ = bt[col_ * 128 + imin(imax(d_, 0), 127)] * at::LOG2E, bfar_ = bt[col_ * 128 + 127] * at::LOG2E; \
              ((LAS float*)(lds + at::L_BIAS))[i_] = bv_; ((LAS float*)(lds + at::L_BIAS))[12 * at::BEXT + i_] = (bv_ - bfar_) / ((col_ < 8 ? 0.125f : 0.17677669529663687f) * at::LOG2E); } } while (0)
          FILL_BIAS_TABLES();
          __syncthreads();
          { unsigned* qhead = (unsigned*)(ws + WS_QCTR) + layer * 64; unsigned* prep_done = (unsigned*)(ws + WS_QCTR) + 128 + layer * 64;
            volatile LAS int* slotp = (volatile LAS int*)(lds + LDS_BYTES - 32);
            bool prep_seen = false;
            for (;;) {
                if (tid == 0) *slotp = (int)atomicAdd(qhead, 1u);
                __syncthreads();
                const int s = *slotp;
                __syncthreads();
                if (s >= 1120) break;
                if (s < 96) {
                    const int tid_p = opq_tid();
                    if (s < 64) { const int kv = s >> 5, tile = s & 31;
                        if (tile == 0) ((bf16_t*)(ws + (kv ? WS_VC : WS_KC)))[((tid_p >> 6) * 128 + 127) * 64 + (tid_p & 63)] = 0;
                        at::compress_unit(proj, kv ? C_NVC : C_NKC, args.in[kv ? 8 : 7] + layer * 2048, (const bf16_t*)(ws + WS_CW1) + (size_t)(layer * 2 + kv) * 256 * 2048,
                                          (const bf16_t*)(ws + WS_CW2) + (size_t)(layer * 2 + kv) * 64 * 256, (bf16_t*)(ws + (kv ? WS_VC : WS_KC)), lds, tile); }
                    else at::kmean_item(proj, (float*)(ws + WS_KMEAN), (s - 64) * 8 + __builtin_amdgcn_readfirstlane(tid_p >> 6), tid_p & 63);
                    if (s < 64) FILL_BIAS_TABLES();
                    asm volatile("s_waitcnt vmcnt(0)" ::: "memory");
                    __syncthreads();
                    if (tid == 0) { __builtin_amdgcn_fence(__ATOMIC_RELEASE, "agent"); asm volatile("s_waitcnt vmcnt(0)" ::: "memory"); __hip_atomic_fetch_add(prep_done, 1u, __ATOMIC_RELAXED, __HIP_MEMORY_SCOPE_AGENT); }
                    continue;
                }
                if (s < 352) { const int i = s - 96; at::diff_unit(proj, args.in[14] + layer * 64, lam, 1.0f - lambda_init, mixed, lds, (i & 31) >> 2, i & 3, 7 - (i >> 5)); continue; }
                if (s >= 864) { const int i = s - 864; at::sb_unit(proj, mixed, lds, (i & 31) >> 2, i & 3, 7 - (i >> 5)); continue; }
                if (!prep_seen) {
                    if (tid == 0) { while (__hip_atomic_load(prep_done, __ATOMIC_RELAXED, __HIP_MEMORY_SCOPE_AGENT) < 96u) __builtin_amdgcn_s_sleep(8);
                                    __builtin_amdgcn_fence(__ATOMIC_ACQUIRE, "agent"); asm volatile("s_waitcnt vmcnt(0)" ::: "memory"); }
                    __syncthreads(); prep_seen = true; }
                { const int r = (s - 352) >> 6, w = (s - 352) & 63, i = w & 31;
                  if (w < 32) at::nsa_unit(proj, (const bf16_t*)(ws + WS_KC), (const bf16_t*)(ws + WS_VC), mixed, lds, i & 7, 31 - 4 * r - (i >> 3));
                  else at::moba_unit(proj, (const float*)(ws + WS_KMEAN), mixed, lds, i >> 2, i & 3, 7 - r); }
            } }
          }
#endif
        XBAR();
#ifndef NO_P4
        { unsigned char* ws = opq(args.ws); const int G = gridDim.x, bid = blockIdx.x; float* xres = opq(args.out);
          pg8::Gemm g{(const bf16_t*)(ws + WS_MIXED), (const bf16_t*)(ws + WS_WOUT) + (size_t)layer * DM * DM, M_TOK, DM, DM}; pg8::StaticOrder S; S.init(M_TOK, DM, G, bid);
          pg8::EpiResidual E{layer == 0 ? args.in[0] : (const float*)xres, xres, (bf16_t*)(ws + WS_XB), (float*)(ws + WS_ROWSS) + (size_t)(2 * layer + 1) * M_TOK, DM};
          pg8::gemm_phase<pg8::EpiResidual, pg8::StaticOrder, true, true>(lds, g, S, E); }
#endif
        XBAR();
#ifndef NO_P5
        { unsigned char* ws = opq(args.ws); const int G = gridDim.x, bid = blockIdx.x;
          pg8::Gemm g{(const bf16_t*)(ws + WS_XB), (const bf16_t*)(ws + WS_WUP) + (size_t)layer * DFF * DM, M_TOK, DFF, DM}; pg8::StaticOrder S; S.init(M_TOK, DFF, G, bid);
          pg8::EpiScale<1> E{(bf16_t*)(ws + WS_PROJ), DFF, (const float*)(ws + WS_ROWSS) + (size_t)(2 * layer + 1) * M_TOK, 1.0f / DM};
          pg8::gemm_phase<pg8::EpiScale<1>, pg8::StaticOrder, true, true>(lds, g, S, E); }
#endif
        XBAR();
#ifndef NO_P6
        { unsigned char* ws = opq(args.ws); const int G = gridDim.x, bid = blockIdx.x; float* xres = opq(args.out);
          pg8::Gemm g{(const bf16_t*)(ws + WS_PROJ), (const bf16_t*)(ws + WS_WDOWN) + (size_t)layer * DM * DFF, M_TOK, DM, DFF}; pg8::StaticOrder S; S.init(M_TOK, DM, G, bid);
          pg8::EpiResidual E{xres, xres, (bf16_t*)(ws + WS_XB), (float*)(ws + WS_ROWSS) + (size_t)(2 * layer + 2) * M_TOK, DM};
          pg8::gemm_phase<pg8::EpiResidual, pg8::StaticOrder, true, true>(lds, g, S, E); }
#endif
        XBAR();
    }
    { const int tid = opq_tid(), lane = tid & 63, wave = __builtin_amdgcn_readfirstlane(tid >> 6), gw = blockIdx.x * 8 + wave, NGW = gridDim.x * 8;
      float* xres = opq(args.out); const float* final_norm = args.in[16];
      for (int m = gw; m < M_TOK; m += NGW) {
        f32x4* xr = (f32x4*)(xres + (size_t)m * DM) + lane; const f32x4* gr = (const f32x4*)final_norm + lane; f32x4 v[4]; float s = 0.f;
#pragma unroll
        for (int j = 0; j < 4; ++j) { v[j] = xr[64 * j]; s += (v[j].x * v[j].x + v[j].y * v[j].y) + (v[j].z * v[j].z + v[j].w * v[j].w); }
        const float rs = 1.0f / sqrtf(wave_sum(s) * (1.0f / DM) + 1e-6f);
#pragma unroll
        for (int j = 0; j < 4; ++j) xr[64 * j] = v[j] * rs * gr[64 * j];
      } }
}

extern "C" void kernel_launch(void* const* d_in, const int* in_sizes, int n_in, void* d_out, int out_size, void* d_ws, size_t ws_size, hipStream_t stream) {
    static int grid = 0;
    if (grid == 0) {
        int dev = 0, cus = 0, per_cu = 0;
        if (n_in != 17 || out_size != M_TOK * DM || ws_size < WS_END) { fprintf(stderr, "kernel_launch: unexpected shapes (n_in %d out %d ws %zu)\n", n_in, out_size, ws_size); grid = -1; return; }
        (void)hipGetDevice(&dev); (void)hipDeviceGetAttribute(&cus, hipDeviceAttributeMultiprocessorCount, dev);
        if (hipFuncSetAttribute((const void*)hybrid_fwd, hipFuncAttributeMaxDynamicSharedMemorySize, LDS_BYTES) != hipSuccess) { fprintf(stderr, "kernel_launch: hipFuncSetAttribute failed\n"); grid = -1; return; }
        if (hipOccupancyMaxActiveBlocksPerMultiprocessor(&per_cu, (const void*)hybrid_fwd, 512, LDS_BYTES) != hipSuccess || per_cu < 1) { fprintf(stderr, "kernel_launch: occupancy query gave %d\n", per_cu); grid = -1; return; }
        grid = cus * per_cu;
    }
    if (grid < 0) return;
    if (hipMemsetAsync((char*)d_ws + WS_BAR, 0, 16384, stream) != hipSuccess) { fprintf(stderr, "kernel_launch: hipMemsetAsync failed\n"); return; }
    Args a{};
    for (int i = 0; i < 17; ++i) a.in[i] = (const float*)d_in[i];
    a.out = (float*)d_out; a.ws = (unsigned char*)d_ws;
    void* kargs[] = {&a};
    hipError_t e = hipLaunchCooperativeKernel((const void*)hybrid_fwd, dim3(grid), dim3(512), kargs, LDS_BYTES, stream);
    if (e != hipSuccess) fprintf(stderr, "cooperative launch failed: %s (grid %d)\n", hipGetErrorString(e), grid);
}
```
